# Optimizing an MI355X kernel written in HIP

```python
import jax, jax.numpy as jnp
from jax import lax
import numpy as np

D_MODEL = 1024
BATCH = 4
SEQ = 8192
DEPTH = 2

D_MIX = D_MODEL
LRU_WIDTH = D_MIX // 2
LRU_BLOCKS = 8
LRU_BLOCK = LRU_WIDTH // LRU_BLOCKS
LRU_CONV = 4
LRU_C = 8.0
RET_HEADS = 4
RET_WIDTH = D_MIX // 4
RET_HEAD_DIM = RET_WIDTH // RET_HEADS
RET_CHUNK = 128
ROPE_BASE = 10000.0
HG_HEADS = 4
HG_WIDTH = D_MIX // 4
HG_HEAD_DIM = HG_WIDTH // HG_HEADS
HG_CHUNK = 64
IN_SPLITS = [LRU_WIDTH, LRU_WIDTH] + [RET_WIDTH] * 4 + [HG_WIDTH] * 4
IN_COLS = sum(IN_SPLITS)
D_FF = ((8 * D_MODEL // 3 + 255) // 256) * 256
FFN_CONV = 3
NORM_EPS = 1e-6

kernel_name = "hymba_style_rglru_retention_hgrn2_convffn"


def rmsnorm(x, w):
    xf = x.astype(jnp.float32)
    y = xf * lax.rsqrt(jnp.mean(xf * xf, axis=-1, keepdims=True) + NORM_EPS)
    return (y * w.astype(jnp.float32)).astype(x.dtype)


def head_rmsnorm(o, w):
    B, S, H, d = o.shape
    y = o * lax.rsqrt(jnp.mean(o * o, axis=-1, keepdims=True) + NORM_EPS)
    return y.reshape(B, S, H * d) * w.astype(jnp.float32)


def causal_dwconv(x, w, b):
    K = w.shape[0]
    S = x.shape[1]
    xp = jnp.pad(x, ((0, 0), (K - 1, 0), (0, 0)))
    y = b + xp[:, 0:S] * w[0]
    for k in range(1, K):
        y = y + xp[:, k:k + S] * w[k]
    return y


def rotary(x):
    S, d = x.shape[1], x.shape[-1]
    inv = ROPE_BASE ** (-jnp.arange(0, d, 2, dtype=jnp.float32) / d)
    ang = jnp.arange(S, dtype=jnp.float32)[:, None] * inv[None, :]
    cos = jnp.cos(ang)[None, :, None, :]
    sin = jnp.sin(ang)[None, :, None, :]
    x1, x2 = x[..., : d // 2], x[..., d // 2:]
    return jnp.concatenate([x1 * cos - x2 * sin, x2 * cos + x1 * sin], axis=-1)


def to_chunks(x, C):
    B, S, H, d = x.shape
    return x.reshape(B, S // C, C, H, d).transpose(1, 0, 3, 2, 4)


def from_chunks(x):
    NC, B, H, C, d = x.shape
    return x.transpose(1, 0, 3, 2, 4).reshape(B, NC * C, H, d)


def rglru_group(xr, gr, conv_w, conv_b, wa, ba, wx, bx, lam):
    dt = xr.dtype
    xc = causal_dwconv(xr, conv_w, conv_b).astype(jnp.float32)
    B, S, _ = xc.shape
    xb = xc.reshape(B, S, LRU_BLOCKS, LRU_BLOCK)
    r = jax.nn.sigmoid(jnp.einsum('bshi,hij->bshj', xb, wa.astype(jnp.float32)).reshape(B, S, LRU_WIDTH) + ba.astype(jnp.float32))
    i = jax.nn.sigmoid(jnp.einsum('bshi,hij->bshj', xb, wx.astype(jnp.float32)).reshape(B, S, LRU_WIDTH) + bx.astype(jnp.float32))
    log_a = -LRU_C * r * jax.nn.softplus(-lam.astype(jnp.float32))
    a = jnp.exp(log_a)
    u = jnp.sqrt(-jnp.expm1(2.0 * log_a)) * (i * xc)

    def combine(c1, c2):
        a1, b1 = c1
        a2, b2 = c2
        return a1 * a2, a2 * b1 + b2

    _, h = lax.associative_scan(combine, (a, u), axis=1)
    return (h * jax.nn.gelu(gr.astype(jnp.float32))).astype(dt)


def retention_group(q, k, v, g, norm_w):
    dt = q.dtype
    B, S, _ = q.shape
    H, dh, C = RET_HEADS, RET_HEAD_DIM, RET_CHUNK
    q = rotary(q.astype(jnp.float32).reshape(B, S, H, dh))
    k = rotary(k.astype(jnp.float32).reshape(B, S, H, dh)) * (dh ** -0.5)
    v = v.astype(jnp.float32).reshape(B, S, H, dh)
    log_gamma = jnp.log1p(-jnp.exp2(-5.0 - jnp.arange(H, dtype=jnp.float32)))
    idx = jnp.arange(C, dtype=jnp.float32)
    rel = idx[:, None] - idx[None, :]
    intra = jnp.where(rel >= 0, jnp.exp(jnp.maximum(rel, 0.0) * log_gamma[:, None, None]), 0.0)
    q_dec = jnp.exp((idx + 1.0)[None, :] * log_gamma[:, None])[..., None]
    k_dec = jnp.exp((C - 1.0 - idx)[None, :] * log_gamma[:, None])[..., None]
    chunk_dec = jnp.exp(C * log_gamma)[:, None, None]

    def step(state, inp):
        qc, kc, vc = inp
        scores = jnp.einsum('bhnd,bhmd->bhnm', qc, kc) * intra
        o = jnp.einsum('bhnm,bhme->bhne', scores, vc) + jnp.einsum('bhnd,bhde->bhne', qc, state) * q_dec
        state = state * chunk_dec + jnp.einsum('bhmd,bhme->bhde', kc * k_dec, vc)
        return state, o

    state0 = jnp.zeros((B, H, dh, dh), jnp.float32)
    _, o = lax.scan(step, state0, (to_chunks(q, C), to_chunks(k, C), to_chunks(v, C)))
    y = head_rmsnorm(from_chunks(o), norm_w)
    return (y * jax.nn.silu(g.astype(jnp.float32))).astype(dt)


def hgrn2_group(q, fpre, i, g, lb, norm_w):
    dt = q.dtype
    B, S, _ = q.shape
    H, dh, C = HG_HEADS, HG_HEAD_DIM, HG_CHUNK
    q = jax.nn.silu(q.astype(jnp.float32)).reshape(B, S, H, dh)
    fp = fpre.astype(jnp.float32).reshape(B, S, H, dh)
    lb = lb.reshape(H, dh)
    log_f = jnp.logaddexp(jnp.log(lb), jnp.log1p(-lb) + jax.nn.log_sigmoid(fp))
    k = (1.0 - lb) * jax.nn.sigmoid(-fp)
    v = i.astype(jnp.float32).reshape(B, S, H, dh)
    mask = jnp.tril(jnp.ones((C, C), dtype=bool))[None, None, :, :, None]

    def step(state, inp):
        qc, kc, gc, vc = inp
        b = jnp.cumsum(gc, axis=2)
        diff = b[:, :, :, None, :] - b[:, :, None, :, :]
        decay = jnp.exp(jnp.where(mask, diff, -jnp.inf))
        scores = jnp.einsum('bhnd,bhmd,bhnmd->bhnm', qc, kc, decay)
        o = jnp.einsum('bhnm,bhme->bhne', scores, vc) + jnp.einsum('bhnd,bhde->bhne', qc * jnp.exp(b), state)
        b_last = b[:, :, -1:, :]
        state = state * jnp.exp(b_last[:, :, 0, :, None]) + jnp.einsum('bhmd,bhme->bhde', kc * jnp.exp(b_last - b), vc)
        return state, o

    state0 = jnp.zeros((B, H, dh, dh), jnp.float32)
    _, o = lax.scan(step, state0, (to_chunks(q, C), to_chunks(k, C), to_chunks(log_f, C), to_chunks(v, C)))
    y = head_rmsnorm(from_chunks(o), norm_w)
    return (y * jax.nn.silu(g.astype(jnp.float32))).astype(dt)


def conv_ffn(h, w_up, conv_w, conv_b, w_down):
    u = causal_dwconv(h @ w_up, conv_w, conv_b)
    gate, val = jnp.split(u, 2, axis=-1)
    return (jax.nn.silu(gate) * val) @ w_down


def setup_inputs(seed: int = 0) -> dict:
    key = jax.random.key(seed)
    ks = jax.random.split(key, 24)
    f32 = jnp.float32
    nrm = lambda k, shape, s: jax.random.normal(k, shape, f32) * s
    u = jax.random.uniform(ks[9], (DEPTH, LRU_WIDTH), f32, 0.9, 0.999)
    a0 = u ** (1.0 / LRU_C)
    lam = jnp.log(a0) - jnp.log1p(-a0)
    return {
        "x": nrm(ks[0], (BATCH, SEQ, D_MODEL), 1.0),
        "norm1_w": 1.0 + nrm(ks[1], (DEPTH, D_MODEL), 0.02),
        "w_in": nrm(ks[2], (DEPTH, D_MODEL, IN_COLS), D_MODEL ** -0.5),
        "lru_conv_w": nrm(ks[3], (DEPTH, LRU_CONV, LRU_WIDTH), LRU_CONV ** -0.5),
        "lru_conv_b": nrm(ks[4], (DEPTH, LRU_WIDTH), 0.01),
        "lru_wa": nrm(ks[5], (DEPTH, LRU_BLOCKS, LRU_BLOCK, LRU_BLOCK), LRU_BLOCK ** -0.5),
        "lru_ba": nrm(ks[6], (DEPTH, LRU_WIDTH), 0.01),
        "lru_wx": nrm(ks[7], (DEPTH, LRU_BLOCKS, LRU_BLOCK, LRU_BLOCK), LRU_BLOCK ** -0.5),
        "lru_bx": nrm(ks[8], (DEPTH, LRU_WIDTH), 0.01),
        "lru_lambda": lam,
        "ret_norm_w": 1.0 + nrm(ks[10], (DEPTH, RET_WIDTH), 0.02),
        "hg_lower_bounds": nrm(ks[11], (DEPTH, HG_WIDTH), 0.5),
        "hg_norm_w": 1.0 + nrm(ks[12], (DEPTH, HG_WIDTH), 0.02),
        "w_out": nrm(ks[13], (DEPTH, D_MIX, D_MODEL), D_MIX ** -0.5),
        "norm2_w": 1.0 + nrm(ks[14], (DEPTH, D_MODEL), 0.02),
        "ffn_w_up": nrm(ks[15], (DEPTH, D_MODEL, 2 * D_FF), D_MODEL ** -0.5),
        "ffn_conv_w": nrm(ks[16], (DEPTH, FFN_CONV, 2 * D_FF), FFN_CONV ** -0.5),
        "ffn_conv_b": nrm(ks[17], (DEPTH, 2 * D_FF), 0.01),
        "ffn_w_down": nrm(ks[18], (DEPTH, D_FF, D_MODEL), D_FF ** -0.5),
        "final_norm_w": 1.0 + nrm(ks[19], (D_MODEL,), 0.02),
    }


def reference(x, norm1_w, w_in, lru_conv_w, lru_conv_b, lru_wa, lru_ba, lru_wx, lru_bx,
              lru_lambda, ret_norm_w, hg_lower_bounds, hg_norm_w, w_out, norm2_w,
              ffn_w_up, ffn_conv_w, ffn_conv_b, ffn_w_down, final_norm_w):
    lb_all = jnp.cumsum(jax.nn.softmax(hg_lower_bounds.astype(jnp.float32), axis=0), axis=0)
    lb_all = lb_all - lb_all[0:1]
    split_idx = list(np.cumsum(IN_SPLITS)[:-1])
    for l in range(DEPTH):
        h = rmsnorm(x, norm1_w[l])
        proj = h @ w_in[l]
        lx, lg, rq, rk, rv, rg, hq, hf, hi, hg = jnp.split(proj, split_idx, axis=-1)
        y_lru = rglru_group(lx, lg, lru_conv_w[l], lru_conv_b[l], lru_wa[l], lru_ba[l],
                            lru_wx[l], lru_bx[l], lru_lambda[l])
        y_ret = retention_group(rq, rk, rv, rg, ret_norm_w[l])
        y_hg = hgrn2_group(hq, hf, hi, hg, lb_all[l], hg_norm_w[l])
        x = x + jnp.concatenate([y_lru, y_ret, y_hg], axis=-1) @ w_out[l]
        h = rmsnorm(x, norm2_w[l])
        x = x + conv_ffn(h, ffn_w_up[l], ffn_conv_w[l], ffn_conv_b[l], ffn_w_down[l])
    return rmsnorm(x, final_norm_w)
```

```cpp
#include <hip/hip_runtime.h>
#include <hip/hip_cooperative_groups.h>
#include <cstdio>
#include <cstdint>
namespace cg = cooperative_groups;

#ifndef MK_ONE_LAUNCH
#define MK_ONE_LAUNCH 0
#endif

#define LAS __attribute__((address_space(3)))
typedef unsigned short bf16_t;
typedef short bf16x8 __attribute__((ext_vector_type(8)));
typedef float f32x4 __attribute__((ext_vector_type(4)));
typedef unsigned u32x4 __attribute__((ext_vector_type(4)));

constexpr int BATCH = 4, SEQ = 8192, DM = 1024, MROWS = BATCH * SEQ;
constexpr int NIN = 3072, DFF = 2816, NUP = 2 * DFF;
constexpr int NCH = SEQ / 64;
constexpr float EPS = 1e-6f;
constexpr int C_LX = 0, C_LG = 512, C_RQ = 1024, C_RK = 1280, C_RV = 1536, C_RG = 1792, C_HQ = 2048, C_HF = 2304, C_HI = 2560, C_HG = 2816;
constexpr int UPU = 33;

constexpr size_t MiB = 1u << 20;
constexpr size_t WS_WIN = 1 * MiB;
constexpr size_t WS_WOUT = 13 * MiB;
constexpr size_t WS_WUP = 17 * MiB;
constexpr size_t WS_WDN = 39 * MiB;
constexpr size_t WS_GATE = 50 * MiB;
constexpr size_t WS_ROPE = 51 * MiB;
constexpr size_t WS_SSQ = 53 * MiB;
constexpr size_t WS_LRUA = 55 * MiB;
constexpr size_t WS_LRUH = 56 * MiB;
constexpr size_t WS_LRUIN = 57 * MiB;
constexpr size_t WS_HGDEC = 58 * MiB;
constexpr size_t WS_XB = 64 * MiB;
constexpr size_t WS_R1 = 128 * MiB;
constexpr size_t WS_Y = 320 * MiB;
constexpr size_t WS_P = 384 * MiB;
constexpr size_t WS_SRET = 416 * MiB;
constexpr size_t WS_SHG = 448 * MiB;
constexpr size_t WS_END = 480 * MiB;

constexpr int LDS_BYTES = 147456;
constexpr int NTHREADS = 512;

__device__ __forceinline__ unsigned f2bf(float f) { unsigned u = __builtin_bit_cast(unsigned, f); return (u + 0x7fffu + ((u >> 16) & 1u)) >> 16; }
__device__ __forceinline__ unsigned pk2(float lo, float hi) { return f2bf(lo) | (f2bf(hi) << 16); }
__device__ __forceinline__ u32x4 pack8(const float (&v)[8]) { u32x4 w; w.x = pk2(v[0], v[1]); w.y = pk2(v[2], v[3]); w.z = pk2(v[4], v[5]); w.w = pk2(v[6], v[7]); return w; }
__device__ __forceinline__ void unpack8(u32x4 w, float (&o)[8]) {
    o[0] = __uint_as_float(w.x << 16); o[1] = __uint_as_float(w.x & 0xffff0000u); o[2] = __uint_as_float(w.y << 16); o[3] = __uint_as_float(w.y & 0xffff0000u);
    o[4] = __uint_as_float(w.z << 16); o[5] = __uint_as_float(w.z & 0xffff0000u); o[6] = __uint_as_float(w.w << 16); o[7] = __uint_as_float(w.w & 0xffff0000u);
}
__device__ __forceinline__ void ld8bf(const bf16_t* p, float (&o)[8]) { unpack8(*(const u32x4*)p, o); }
__device__ __forceinline__ float sigmoidf_(float x) { return 1.0f / (1.0f + __expf(-x)); }
template <int N> __device__ __forceinline__ float dpp_ror(float v) { return __builtin_bit_cast(float, __builtin_amdgcn_update_dpp(0, __builtin_bit_cast(int, v), 0x120 + N, 0xf, 0xf, false)); }
__device__ __forceinline__ float gelu_tanh(float x) { const float z = 0.7978845608028654f * (x + 0.044715f * x * x * x); const float t = 1.0f - 2.0f / (__expf(2.0f * z) + 1.0f); return 0.5f * x * (1.0f + t); }
__device__ __forceinline__ float rstd_q(const float* ssq, int row, int fq) {
    const f32x4 p = *(const f32x4*)(ssq + (size_t)row * 16 + 4 * fq);
    float s = (p[0] + p[1]) + (p[2] + p[3]);
    s += __shfl_xor(s, 16); s += __shfl_xor(s, 32);
    return rsqrtf(s * (1.0f / DM) + EPS);
}
__device__ __forceinline__ float rstd_of(const float* ssq, int row) {
    const f32x4* p = (const f32x4*)(ssq + (size_t)row * 16);
    const f32x4 a = p[0], b = p[1], c = p[2], d = p[3];
    const float s = ((a[0] + a[1]) + (a[2] + a[3])) + ((b[0] + b[1]) + (b[2] + b[3])) + ((c[0] + c[1]) + (c[2] + c[3])) + ((d[0] + d[1]) + (d[2] + d[3]));
    return rsqrtf(s * (1.0f / DM) + EPS);
}
#define LDS_WAIT() asm volatile("s_waitcnt lgkmcnt(0)" ::: "memory")

namespace pg8 {
#define PG8_LAS __attribute__((address_space(3)))
constexpr int BM = 256, BK = 64, HALF = 128, HTB = HALF * BK * 2, NXCD = 8, WGM = 8;
__host__ __device__ __forceinline__ int lds_byte(int r, int c) { const int st = (r >> 4) * 2 + (c >> 5), rr = r & 15, cc = c & 31, ob = rr * 64 + cc * 2; return st * 1024 + (ob ^ (((ob >> 9) & 1) << 5)); }
__host__ __device__ __forceinline__ void stage_rc(int b, int& R, int& C) { const int st = b / 1024, sb = b % 1024, swz = sb ^ (((sb >> 9) & 1) << 5); R = (st >> 1) * 16 + swz / 64; C = (st & 1) * 32 + (swz % 64) / 2; }
__host__ __device__ __forceinline__ int perm32(int rho) { const int n = rho >> 4, i = rho & 15; return 8 * (i >> 2) + 4 * n + (i & 3); }

struct Unit { int pm, pn; };
struct Gemm { const bf16_t* A; const bf16_t* Bt; int K; };

struct StaticOrder {
    int nM, nN, nwg, G, c;
    __host__ __device__ void init(int nM_, int nN_, int G_, int c_) { nM = nM_; nN = nN_; nwg = nM * nN; G = G_; c = c_; }
    __host__ __device__ bool next(int i, Unit& u) const {
        const long L = (long)i * G + c; if (L >= nwg) return false;
        int wgid = (int)L; { const int q = nwg / NXCD, r = nwg % NXCD, xcd = wgid % NXCD, off = wgid / NXCD; wgid = (xcd < r ? xcd * (q + 1) : r * (q + 1) + (xcd - r) * q) + off; }
        const int nig = WGM * nN, gid = wgid / nig, fm = gid * WGM, gsz = (nM - fm) < WGM ? (nM - fm) : WGM;
        u.pm = fm + ((wgid % nig) % gsz); u.pn = (wgid % nig) / gsz; return true;
    }
};

template <bool HALO> __device__ __forceinline__ size_t a_unit_off(int pm, int K) {
    if (HALO) return ((size_t)(pm / UPU) * SEQ + (size_t)(pm % UPU) * 252) * (size_t)K * 2;
    return (size_t)pm * 256 * (size_t)K * 2;
}

template <class Epi, bool HALO>
__device__ __forceinline__ void gemm_phase(PG8_LAS unsigned char* lds, const Gemm g, const StaticOrder& S, const Epi& E, const int tid) {
    const int wid = __builtin_amdgcn_readfirstlane(tid >> 6), lane = tid & 63, wr = wid >> 2, wc = wid & 3, fr = lane & 15, fq = lane >> 4;
    const int K = g.K, nt = K / BK;
    int voffA[2], voffB[2];
#pragma unroll
    for (int i = 0; i < 2; ++i) { int R, C; stage_rc(tid * 16 + i * 8192, R, C); const int Rb = (R & ~31) + perm32(R & 31);
        const int Ra = HALO ? (126 * (R >> 6) - 2 + (R & 63)) : R;
        voffA[i] = (Ra * K + C) * 2; voffB[i] = (Rb * K + C) * 2; }
    const size_t kstep = (size_t)(BK * 2);
    const size_t hstepB = (size_t)HALF * K * 2;
    const size_t hstepA = HALO ? (size_t)64 * K * 2 : (size_t)HALF * K * 2;
    const size_t tstepB = 2 * hstepB;
    const unsigned ldsw = (unsigned)wid * 1024u;
    const int aoff = lds_byte(wr * 64 + fr, fq * 8), boff = lds_byte(wc * 32 + fr, fq * 8);
#define PG8_SA(b, h) (((b) * 2 + (h)) * HTB)
#define PG8_SB(b, h) ((4 + (b) * 2 + (h)) * HTB)
#define PG8_STAGE(bufoff, gbase, voff) do { _Pragma("unroll") for (int _i = 0; _i < 2; ++_i) \
        __builtin_amdgcn_global_load_lds((const unsigned*)((const char*)(gbase) + (voff)[_i]), (PG8_LAS unsigned*)(lds + (bufoff) + ldsw + _i * 8192), 16, 0, 0); } while (0)
#define PG8_LDA(dst, b, h) do { _Pragma("unroll") for (int m = 0; m < 4; ++m) _Pragma("unroll") for (int k = 0; k < 2; ++k) dst[m][k] = *(const PG8_LAS bf16x8*)(lds + PG8_SA(b, h) + aoff + m * 2048 + k * 1024); } while (0)
#define PG8_LDB(dst, b, h) do { _Pragma("unroll") for (int n = 0; n < 2; ++n) _Pragma("unroll") for (int k = 0; k < 2; ++k) dst[n][k] = *(const PG8_LAS bf16x8*)(lds + PG8_SB(b, h) + boff + n * 2048 + k * 1024); } while (0)
#define PG8_MMA(ai, bj, At, Bt) do { __builtin_amdgcn_s_setprio(1); _Pragma("unroll") for (int m = 0; m < 4; ++m) _Pragma("unroll") for (int n = 0; n < 2; ++n) _Pragma("unroll") for (int k = 0; k < 2; ++k) \
        acc[ai][bj][m][n] = __builtin_amdgcn_mfma_f32_16x16x32_bf16(Bt[n][k], At[m][k], acc[ai][bj][m][n], 0, 0, 0); __builtin_amdgcn_s_setprio(0); } while (0)
#define PG8_WAIT_V(n) asm volatile("s_waitcnt vmcnt(" #n ")" ::: "memory")
#define PG8_WAIT_L(n) asm volatile("s_waitcnt lgkmcnt(" #n ")" ::: "memory")
#define PG8_BAR __builtin_amdgcn_s_barrier()
#define PG8_SCHED __builtin_amdgcn_sched_barrier(0)
    Unit cur, nxt; int ui = 0;
    if (!S.next(0, cur)) return;
    f32x4 acc[2][2][4][2];
#pragma unroll
    for (int a = 0; a < 2; ++a)
#pragma unroll
        for (int b = 0; b < 2; ++b)
#pragma unroll
            for (int m = 0; m < 4; ++m)
#pragma unroll
                for (int n = 0; n < 2; ++n) acc[a][b][m][n] = (f32x4){0.f, 0.f, 0.f, 0.f};
    bf16x8 At[4][2], B0[2][2], B1[2][2];
    const char* cA = (const char*)g.A + a_unit_off<HALO>(cur.pm, K); const char* cB = (const char*)g.Bt + (size_t)cur.pn * tstepB;
    PG8_STAGE(PG8_SB(0, 0), cB, voffB); PG8_STAGE(PG8_SB(0, 1), cB + hstepB, voffB); PG8_STAGE(PG8_SA(0, 0), cA, voffA); PG8_STAGE(PG8_SA(0, 1), cA + hstepA, voffA);
    if (wr == 1) PG8_BAR;
    PG8_WAIT_V(2); PG8_BAR;
    PG8_STAGE(PG8_SB(1, 0), cB + kstep, voffB); PG8_STAGE(PG8_SA(1, 0), cA + kstep, voffA); PG8_STAGE(PG8_SB(1, 1), cB + hstepB + kstep, voffB);
    PG8_WAIT_V(6); PG8_BAR;
    for (;;) {
        const bool has_next = S.next(ui + 1, nxt);
        const char* nA = has_next ? (const char*)g.A + a_unit_off<HALO>(nxt.pm, K) : cA; const char* nB = has_next ? (const char*)g.Bt + (size_t)nxt.pn * tstepB : cB;
        for (int t = 0; t < nt; t += 2) {
            const bool last = (t == nt - 2);
            const char* a1 = cA + (size_t)(t + 1) * kstep;
            const char* a2 = last ? nA : cA + (size_t)(t + 2) * kstep; const char* b2 = last ? nB : cB + (size_t)(t + 2) * kstep;
            const char* a3 = a2 + kstep; const char* b3 = b2 + kstep;
            PG8_LDB(B0, 0, 0); PG8_LDB(B1, 0, 1); PG8_SCHED; PG8_LDA(At, 0, 0); PG8_STAGE(PG8_SA(1, 1), a1 + hstepA, voffA);
            PG8_WAIT_V(8); PG8_WAIT_L(0); PG8_BAR; PG8_MMA(0, 0, At, B0); PG8_MMA(0, 1, At, B1); PG8_BAR; PG8_SCHED;
            PG8_LDA(At, 0, 1); PG8_STAGE(PG8_SB(0, 0), b2, voffB); PG8_STAGE(PG8_SB(0, 1), b2 + hstepB, voffB); PG8_STAGE(PG8_SA(0, 0), a2, voffA);
            PG8_WAIT_V(8); PG8_WAIT_L(0); PG8_BAR; PG8_MMA(1, 0, At, B0); PG8_MMA(1, 1, At, B1); PG8_BAR; PG8_SCHED;
            PG8_LDB(B0, 1, 0); PG8_LDB(B1, 1, 1); PG8_SCHED; PG8_LDA(At, 1, 0); PG8_STAGE(PG8_SA(0, 1), a2 + hstepA, voffA);
            PG8_WAIT_V(8); PG8_WAIT_L(0); PG8_BAR; PG8_MMA(0, 0, At, B0); PG8_MMA(0, 1, At, B1); PG8_BAR; PG8_SCHED;
            PG8_LDA(At, 1, 1); PG8_STAGE(PG8_SB(1, 0), b3, voffB); PG8_STAGE(PG8_SB(1, 1), b3 + hstepB, voffB); PG8_STAGE(PG8_SA(1, 0), a3, voffA);
            PG8_WAIT_V(8); PG8_WAIT_L(0); PG8_BAR; PG8_MMA(1, 0, At, B0); PG8_MMA(1, 1, At, B1); PG8_BAR; PG8_SCHED;
        }
        if (wr == 0) PG8_BAR;
        E(acc, cur, wr, wc, fr, fq);
        if (!has_next) break;
#pragma unroll
        for (int a = 0; a < 2; ++a)
#pragma unroll
            for (int b = 0; b < 2; ++b)
#pragma unroll
                for (int m = 0; m < 4; ++m)
#pragma unroll
                    for (int n = 0; n < 2; ++n) acc[a][b][m][n] = (f32x4){0.f, 0.f, 0.f, 0.f};
        cur = nxt; cA = nA; cB = nB; ++ui;
        if (wr == 1) PG8_BAR;
    }
    PG8_WAIT_V(0);
    PG8_BAR;
#undef PG8_SA
#undef PG8_SB
#undef PG8_STAGE
#undef PG8_LDA
#undef PG8_LDB
#undef PG8_MMA
#undef PG8_WAIT_V
#undef PG8_WAIT_L
#undef PG8_BAR
#undef PG8_SCHED
}

typedef f32x4 Acc[2][2][4][2];

struct EpiProj {
    bf16_t* O; const float* ssq;
    __device__ __forceinline__ void operator()(Acc& acc, const Unit& u, int wr, int wc, int fr, int fq) const {
        const int row0 = u.pm * 256 + wr * 64 + fr, col0 = u.pn * 256 + wc * 32 + 8 * fq;
#pragma unroll
        for (int ai = 0; ai < 2; ++ai)
#pragma unroll
            for (int m = 0; m < 4; ++m) {
                const int row = row0 + ai * 128 + m * 16; const float rs = rstd_q(ssq, row, fq);
                bf16_t* rowp = O + (size_t)row * NIN + col0;
#pragma unroll
                for (int bj = 0; bj < 2; ++bj) { const f32x4 v0 = acc[ai][bj][m][0] * rs, v1 = acc[ai][bj][m][1] * rs;
                    u32x4 w; w.x = pk2(v0[0], v0[1]); w.y = pk2(v0[2], v0[3]); w.z = pk2(v1[0], v1[1]); w.w = pk2(v1[2], v1[3]);
                    *(u32x4*)(rowp + bj * 128) = w; }
            }
    }
};

struct EpiResid {
    const float* base; float* out; bf16_t* xb; float* ssq;
    __device__ __forceinline__ void operator()(Acc& acc, const Unit& u, int wr, int wc, int fr, int fq) const {
        const int row0 = u.pm * 256 + wr * 64 + fr, col0 = u.pn * 256 + wc * 32 + 8 * fq;
#pragma unroll
        for (int ai = 0; ai < 2; ++ai)
#pragma unroll
            for (int m = 0; m < 4; ++m) {
                const int row = row0 + ai * 128 + m * 16; float ss = 0.f;
#pragma unroll
                for (int bj = 0; bj < 2; ++bj) { const size_t off = (size_t)row * DM + col0 + bj * 128;
                    const f32x4 b0 = *(const f32x4*)(base + off), b1 = *(const f32x4*)(base + off + 4);
                    const f32x4 v0 = acc[ai][bj][m][0] + b0, v1 = acc[ai][bj][m][1] + b1;
                    *(f32x4*)(out + off) = v0; *(f32x4*)(out + off + 4) = v1;
                    u32x4 w; w.x = pk2(v0[0], v0[1]); w.y = pk2(v0[2], v0[3]); w.z = pk2(v1[0], v1[1]); w.w = pk2(v1[2], v1[3]);
                    *(u32x4*)(xb + off) = w;
                    ss += (v0[0] * v0[0] + v0[1] * v0[1]) + (v0[2] * v0[2] + v0[3] * v0[3]) + (v1[0] * v1[0] + v1[1] * v1[1]) + (v1[2] * v1[2] + v1[3] * v1[3]); }
                ss += __shfl_xor(ss, 16); ss += __shfl_xor(ss, 32);
                if (fq == 0) ssq[(size_t)row * 16 + u.pn * 4 + wc] = ss;
            }
    }
};

struct EpiFfn {
    bf16_t* act; const float* ssq; const float* cw; const float* cb;
    __device__ __forceinline__ void operator()(Acc& acc, const Unit& u, int wr, int wc, int fr, int fq) const {
        const int b = u.pm / UPU, j = u.pm % UPU;
        const int tbase = 252 * j + 126 * wr - 2 + fr;
        const int ch0 = 128 * u.pn + 32 * wc + 8 * fq;
        float chain = 0.f;
        float rs8[8];
#pragma unroll
        for (int q = 0; q < 8; ++q) {
            const int t = tbase + 16 * q; const bool ok = (t >= 0) && (t < SEQ);
            const float rs = rstd_q(ssq, b * SEQ + (ok ? t : 0), fq); rs8[q] = ok ? rs : 0.f;
        }
#pragma unroll
        for (int n = 0; n < 2; ++n)
#pragma unroll
            for (int i = 0; i < 4; ++i) {
                const int cg_ = ch0 + 4 * n + i, cv_ = DFF + cg_;
                const float g0 = cw[cg_], g1 = cw[NUP + cg_], g2 = cw[2 * NUP + cg_], gb = cb[cg_];
                const float v0 = cw[cv_], v1 = cw[NUP + cv_], v2 = cw[2 * NUP + cv_], vb = cb[cv_];
                float pg1 = 0.f, pg2 = 0.f, pv1 = 0.f, pv2 = 0.f;
#pragma unroll
                for (int q = 0; q < 8; ++q) {
                    const float ag = acc[q >> 2][0][q & 3][n][i], av = acc[q >> 2][1][q & 3][n][i];
                    float cgv = rs8[q] != 0.f ? ag * rs8[q] : 0.f, cvv = rs8[q] != 0.f ? av * rs8[q] : 0.f;
                    asm volatile("" : "+v"(cgv), "+v"(cvv) : "v"(chain));
                    const float tg1 = dpp_ror<1>(cgv), tg2 = dpp_ror<2>(cgv), tv1 = dpp_ror<1>(cvv), tv2 = dpp_ror<2>(cvv);
                    const float sg1 = fr >= 1 ? tg1 : pg1, sg2 = fr >= 2 ? tg2 : pg2, sv1 = fr >= 1 ? tv1 : pv1, sv2 = fr >= 2 ? tv2 : pv2;
                    const float gg = gb + g0 * sg2 + g1 * sg1 + g2 * cgv;
                    const float vv = vb + v0 * sv2 + v1 * sv1 + v2 * cvv;
                    chain = gg * sigmoidf_(gg) * vv; acc[q >> 2][0][q & 3][n][i] = chain;
                    pg1 = tg1; pg2 = tg2; pv1 = tv1; pv2 = tv2;
                }
                __builtin_amdgcn_sched_barrier(0);
            }
#pragma unroll
        for (int q = 0; q < 8; ++q) {
            const int t = tbase + 16 * q;
            if ((16 * q + fr >= 2) && (t < SEQ)) {
                const f32x4 a0 = acc[q >> 2][0][q & 3][0], a1 = acc[q >> 2][0][q & 3][1];
                u32x4 w; w.x = pk2(a0[0], a0[1]); w.y = pk2(a0[2], a0[3]); w.z = pk2(a1[0], a1[1]); w.w = pk2(a1[2], a1[3]);
                *(u32x4*)(act + (size_t)(b * SEQ + t) * DFF + ch0) = w;
            }
        }
    }
};
}

struct Args { const float* in[20]; float* out; unsigned char* ws; int ph_lo, ph_hi; };
enum { I_X = 0, I_N1, I_WIN, I_LCW, I_LCB, I_WA, I_BA, I_WX, I_BX, I_LAM, I_RNW, I_HLB, I_HNW, I_WOUT, I_N2, I_WUP, I_FCW, I_FCB, I_WDN, I_FNW };

__device__ __forceinline__ void p0_item(const float* W, int K, int N, bf16_t* WT, const float* scale, bool upmap, LAS float* scr, int item, int lane) {
    const int nblk = N / 32, kb = item / nblk, nb = item % nblk, k0 = 64 * kb, n0 = 32 * nb;
#pragma unroll 8
    for (int i = 0; i < 32; ++i) { const int kk = 2 * i + (lane >> 5); float w = W[(size_t)(k0 + kk) * N + n0 + (lane & 31)]; if (scale) w *= scale[k0 + kk]; scr[kk * 33 + (lane & 31)] = w; }
    LDS_WAIT();
    const int c = lane & 7;
#pragma unroll
    for (int j = 0; j < 4; ++j) { const int n = (lane >> 3) + 8 * j; const LAS float* s = scr + (8 * c) * 33 + n;
        u32x4 o; o.x = pk2(s[0 * 33], s[1 * 33]); o.y = pk2(s[2 * 33], s[3 * 33]); o.z = pk2(s[4 * 33], s[5 * 33]); o.w = pk2(s[6 * 33], s[7 * 33]);
        int row = n0 + n;
        if (upmap) { const int bj = row >= DFF ? 1 : 0, ch = row - DFF * bj; row = 256 * (ch >> 7) + 128 * bj + (ch & 127); }
        *(u32x4*)(WT + (size_t)row * K + k0 + 8 * c) = o; }
    LDS_WAIT();
}

__device__ __forceinline__ void p0_prologue(const Args& a, LAS unsigned char* lds, const int tid) {
    const int lane = tid & 63, wave = tid >> 6;
    const int G = gridDim.x, gw = blockIdx.x * 8 + wave, NGW = G * 8;
    unsigned char* ws = a.ws;
    LAS float* scr = (LAS float*)(lds + wave * 16384);
    constexpr int I_IN = 16 * (NIN / 32), I_OUT = 16 * (DM / 32), I_UP = 16 * (NUP / 32), I_DN = (DFF / 64) * (DM / 32);
    constexpr int PER_L = I_IN + I_OUT + I_UP + I_DN;
    for (int it = gw; it < 2 * PER_L; it += NGW) {
        const int l = it / PER_L; int r = it % PER_L;
        if (r < I_IN) { p0_item(a.in[I_WIN] + (size_t)l * DM * NIN, DM, NIN, (bf16_t*)(ws + WS_WIN) + (size_t)l * NIN * DM, a.in[I_N1] + l * DM, false, scr, r, lane); continue; } r -= I_IN;
        if (r < I_OUT) { p0_item(a.in[I_WOUT] + (size_t)l * DM * DM, DM, DM, (bf16_t*)(ws + WS_WOUT) + (size_t)l * DM * DM, nullptr, false, scr, r, lane); continue; } r -= I_OUT;
        if (r < I_UP) { p0_item(a.in[I_WUP] + (size_t)l * DM * NUP, DM, NUP, (bf16_t*)(ws + WS_WUP) + (size_t)l * NUP * DM, a.in[I_N2] + l * DM, true, scr, r, lane); continue; } r -= I_UP;
        p0_item(a.in[I_WDN] + (size_t)l * DFF * DM, DFF, DM, (bf16_t*)(ws + WS_WDN) + (size_t)l * DM * DFF, nullptr, false, scr, r, lane);
    }
    {
        const float* x = a.in[I_X]; bf16_t* xb = (bf16_t*)(ws + WS_XB); float* ssq = (float*)(ws + WS_SSQ);
        for (int m = gw; m < MROWS; m += NGW) {
            const f32x4* xr = (const f32x4*)(x + (size_t)m * DM) + lane; f32x4 v[4]; float s = 0.f;
#pragma unroll
            for (int j = 0; j < 4; ++j) { v[j] = xr[64 * j]; s += (v[j][0] * v[j][0] + v[j][1] * v[j][1]) + (v[j][2] * v[j][2] + v[j][3] * v[j][3]); }
#pragma unroll
            for (int o = 1; o < 64; o <<= 1) s += __shfl_xor(s, o);
            unsigned long long* o8 = (unsigned long long*)(xb + (size_t)m * DM) + lane;
#pragma unroll
            for (int j = 0; j < 4; ++j) o8[64 * j] = (unsigned long long)pk2(v[j][0], v[j][1]) | ((unsigned long long)pk2(v[j][2], v[j][3]) << 32);
            if (lane < 16) ssq[(size_t)m * 16 + lane] = lane == 0 ? s : 0.f;
        }
    }
    {
        const int gt = blockIdx.x * NTHREADS + tid, NT = G * NTHREADS;
        float* cosT = (float*)(ws + WS_ROPE); float* sinT = cosT + SEQ * 32;
        for (int idx = gt; idx < SEQ * 32; idx += NT) { const int pos = idx >> 5, i = idx & 31;
            const float inv = powf(10000.0f, -(float)(2 * i) / 64.0f); const float ang = (float)pos * inv; float s, c; sincosf(ang, &s, &c); cosT[idx] = c; sinT[idx] = s; }
        bf16_t* gw_ = (bf16_t*)(ws + WS_GATE);
        for (int idx = gt; idx < 2 * 2 * 8 * 4096; idx += NT) { const int i = idx & 63, jj = (idx >> 6) & 63, h = (idx >> 12) & 7, ax = (idx >> 15) & 1, l = idx >> 16;
            const float* src = a.in[ax ? I_WX : I_WA] + (size_t)l * 8 * 4096 + h * 4096 + i * 64 + jj; gw_[idx] = (bf16_t)f2bf(*src); }
    }
}

constexpr int LD = 72;
constexpr int TILE_B = 64 * LD * 2;
__device__ __forceinline__ void mm64(f32x4 (&acc)[2], const LAS bf16_t* A, const LAS bf16_t* Bt, int wave, int lane) {
    const int rb = wave >> 1, cb0 = (wave & 1) * 2, fr = lane & 15, fq = lane >> 4;
#pragma unroll
    for (int kk = 0; kk < 2; ++kk) {
        const bf16x8 av = *(const LAS bf16x8*)(A + (16 * rb + fr) * LD + 32 * kk + 8 * fq);
#pragma unroll
        for (int t = 0; t < 2; ++t) {
            const bf16x8 bv = *(const LAS bf16x8*)(Bt + (16 * (cb0 + t) + fr) * LD + 32 * kk + 8 * fq);
            acc[t] = __builtin_amdgcn_mfma_f32_16x16x32_bf16(av, bv, acc[t], 0, 0, 0);
        }
    }
}

struct MixCtx {
    int l; unsigned char* ws; LAS unsigned char* lds; int tid, lane, wave;
    const bf16_t* proj; bf16_t* y;
};

__device__ __forceinline__ float ret_lg(int h) { return log1pf(-exp2f(-5.0f - (float)h)); }

__device__ __forceinline__ float hg_lb(const Args& a, int l, int ch) {
    if (l == 0) return 0.f;
    const float* hb = a.in[I_HLB]; return sigmoidf_(hb[256 + ch] - hb[ch]);
}

__device__ __forceinline__ void lru_m1(const Args& a, const MixCtx& c, int b, int ck_, int h) {
    const int l = c.l, tid = c.tid, lane = c.lane, wave = c.wave;
    LAS bf16_t* xcb = (LAS bf16_t*)c.lds;
    LAS float* xin = (LAS float*)(c.lds + 9216);
    LAS float* xcf = (LAS float*)(c.lds + 26368);
    LAS float* A_ = (LAS float*)(c.lds + 43008);
    LAS float* U_ = (LAS float*)(c.lds + 59648);
    const int row0 = b * SEQ + 64 * ck_;
    for (int idx = tid; idx < 67 * 8; idx += NTHREADS) { const int r = idx >> 3, q = idx & 7, t = 64 * ck_ - 3 + r; float v[8];
#pragma unroll
        for (int i = 0; i < 8; ++i) v[i] = 0.f;
        if (t >= 0) ld8bf(c.proj + (size_t)(b * SEQ + t) * NIN + C_LX + 64 * h + 8 * q, v);
#pragma unroll
        for (int i = 0; i < 8; ++i) xin[r * 64 + 8 * q + i] = v[i]; }
    __syncthreads();
    {
        const float* cw = a.in[I_LCW] + (size_t)l * 4 * 512; const float* cbias = a.in[I_LCB] + l * 512;
        const int tok = tid >> 3, q = tid & 7; float v[8];
#pragma unroll
        for (int i = 0; i < 8; ++i) { const int ch = 64 * h + 8 * q + i; float s = cbias[ch];
#pragma unroll
            for (int k = 0; k < 4; ++k) s += cw[k * 512 + ch] * xin[(tok + k) * 64 + 8 * q + i];
            xcf[tok * 65 + 8 * q + i] = s; v[i] = s; }
        *(LAS u32x4*)(xcb + tok * LD + 8 * q) = pack8(v);
    }
    __syncthreads();
    {
        const bf16_t* gwt = (const bf16_t*)(c.ws + WS_GATE) + (size_t)l * 65536;
        const bf16_t* waT = gwt + h * 4096; const bf16_t* wxT = gwt + 32768 + h * 4096;
        const int rb = wave >> 1, cb0 = (wave & 1) * 2, fr = lane & 15, fq = lane >> 4;
        f32x4 ga[2], gx[2];
#pragma unroll
        for (int t = 0; t < 2; ++t) { ga[t] = (f32x4){0.f, 0.f, 0.f, 0.f}; gx[t] = (f32x4){0.f, 0.f, 0.f, 0.f}; }
#pragma unroll
        for (int kk = 0; kk < 2; ++kk) {
            const bf16x8 av = *(const LAS bf16x8*)(xcb + (16 * rb + fr) * LD + 32 * kk + 8 * fq);
#pragma unroll
            for (int t = 0; t < 2; ++t) { const int jj = 16 * (cb0 + t) + fr;
                const bf16x8 ba_ = *(const bf16x8*)(waT + jj * 64 + 32 * kk + 8 * fq), bx_ = *(const bf16x8*)(wxT + jj * 64 + 32 * kk + 8 * fq);
                ga[t] = __builtin_amdgcn_mfma_f32_16x16x32_bf16(av, ba_, ga[t], 0, 0, 0);
                gx[t] = __builtin_amdgcn_mfma_f32_16x16x32_bf16(av, bx_, gx[t], 0, 0, 0); }
        }
        const float* ba = a.in[I_BA] + l * 512; const float* bx = a.in[I_BX] + l * 512; const float* lam = a.in[I_LAM] + l * 512;
#pragma unroll
        for (int t = 0; t < 2; ++t) { const int jj = 16 * (cb0 + t) + fr, ch = 64 * h + jj;
            const float bav = ba[ch], bxv = bx[ch], sp = log1pf(__expf(-lam[ch]));
#pragma unroll
            for (int r = 0; r < 4; ++r) { const int tok = 16 * rb + 4 * fq + r;
                const float rg = sigmoidf_(ga[t][r] + bav), ig = sigmoidf_(gx[t][r] + bxv);
                const float la = -8.0f * rg * sp; const float av_ = __expf(la);
                const float uv = sqrtf(-expm1f(2.0f * la)) * (ig * xcf[tok * 65 + jj]);
                A_[tok * 65 + jj] = av_; U_[tok * 65 + jj] = uv; }
        }
    }
    __syncthreads();
    if (tid < 64) { float hh = 0.f, P = 1.f;
        for (int t = 0; t < 64; ++t) { const float av_ = A_[t * 65 + tid], uv = U_[t * 65 + tid]; hh = av_ * hh + uv; P *= av_; U_[t * 65 + tid] = hh; A_[t * 65 + tid] = P; }
        const size_t so = (size_t)(b * NCH + ck_) * 512 + 64 * h + tid;
        ((float*)(c.ws + WS_LRUA))[so] = P; ((float*)(c.ws + WS_LRUH))[so] = hh; }
    __syncthreads();
    { const int tok = tid >> 3, q = tid & 7; float hv[8], pv[8];
#pragma unroll
        for (int i = 0; i < 8; ++i) { hv[i] = U_[tok * 65 + 8 * q + i]; pv[i] = A_[tok * 65 + 8 * q + i]; }
        *(u32x4*)(c.y + (size_t)(row0 + tok) * DM + 64 * h + 8 * q) = pack8(hv);
        *(u32x4*)((bf16_t*)(c.ws + WS_P) + (size_t)(row0 + tok) * 512 + 64 * h + 8 * q) = pack8(pv); }
    __syncthreads();
}

__device__ __forceinline__ void lru_m3(const MixCtx& c, int b, int ck_, int h) {
    const int tok = c.tid >> 3, q = c.tid & 7, row = b * SEQ + 64 * ck_ + tok, col = 64 * h + 8 * q;
    float hl[8], pv[8], g[8], o[8];
    ld8bf(c.y + (size_t)row * DM + col, hl); ld8bf((const bf16_t*)(c.ws + WS_P) + (size_t)row * 512 + col, pv); ld8bf(c.proj + (size_t)row * NIN + C_LG + col, g);
    const float* hin = (const float*)(c.ws + WS_LRUIN) + (size_t)(b * NCH + ck_) * 512 + col;
#pragma unroll
    for (int i = 0; i < 8; ++i) o[i] = (hl[i] + pv[i] * hin[i]) * gelu_tanh(g[i]);
    *(u32x4*)(c.y + (size_t)row * DM + col) = pack8(o);
}

__device__ __forceinline__ void rot8(const MixCtx& c, const bf16_t* src, int pos, int cp, float (&o1)[8], float (&o2)[8]) {
    float x1[8], x2[8]; ld8bf(src + 8 * cp, x1); ld8bf(src + 32 + 8 * cp, x2);
    const float* cosT = (const float*)(c.ws + WS_ROPE) + pos * 32 + 8 * cp; const float* sinT = cosT + SEQ * 32;
#pragma unroll
    for (int i = 0; i < 8; ++i) { const float cs = cosT[i], sn = sinT[i]; o1[i] = x1[i] * cs - x2[i] * sn; o2[i] = x2[i] * cs + x1[i] * sn; }
}
__device__ __forceinline__ void store_vT(const MixCtx& c, LAS bf16_t* vT, int row0, int vcol) {
    const int r = c.tid >> 3, q = c.tid & 7; const u32x4 w = *(const u32x4*)(c.proj + (size_t)(row0 + r) * NIN + vcol + 8 * q);
    const unsigned ww[4] = {w.x, w.y, w.z, w.w};
#pragma unroll
    for (int i = 0; i < 8; ++i) vT[(8 * q + i) * LD + r] = (bf16_t)((ww[i >> 1] >> (16 * (i & 1))) & 0xffffu);
}
__device__ __forceinline__ void store_state(f32x4 (&acc)[2], float* S, int wave, int lane) {
    const int rb = wave >> 1, cb0 = (wave & 1) * 2, fr = lane & 15, fq = lane >> 4;
#pragma unroll
    for (int t = 0; t < 2; ++t)
#pragma unroll
        for (int r = 0; r < 4; ++r) S[(16 * rb + 4 * fq + r) * 64 + 16 * (cb0 + t) + fr] = acc[t][r];
}

__device__ __forceinline__ void ret_m1(const MixCtx& c, int b, int ck_, int h) {
    LAS bf16_t* kdT = (LAS bf16_t*)c.lds; LAS bf16_t* vT = (LAS bf16_t*)(c.lds + TILE_B);
    const int row0 = b * SEQ + 64 * ck_;
    if (c.tid < 256) { const int r = c.tid >> 2, cp = c.tid & 3; float o1[8], o2[8];
        rot8(c, c.proj + (size_t)(row0 + r) * NIN + C_RK + 64 * h, 64 * ck_ + r, cp, o1, o2);
        const float sc = 0.125f * __expf((float)(63 - r) * ret_lg(h));
#pragma unroll
        for (int i = 0; i < 8; ++i) { kdT[(8 * cp + i) * LD + r] = (bf16_t)f2bf(o1[i] * sc); kdT[(32 + 8 * cp + i) * LD + r] = (bf16_t)f2bf(o2[i] * sc); } }
    store_vT(c, vT, row0, C_RV + 64 * h);
    __syncthreads();
    f32x4 acc[2] = {(f32x4){0.f, 0.f, 0.f, 0.f}, (f32x4){0.f, 0.f, 0.f, 0.f}};
    mm64(acc, vT, kdT, c.wave, c.lane);
    store_state(acc, (float*)(c.ws + WS_SRET) + (size_t)((b * NCH + ck_) * 4 + h) * 4096, c.wave, c.lane);
    __syncthreads();
}

__device__ __forceinline__ void hg_fk(const Args& a, const MixCtx& c, int row, int h, int q, LAS float* LF, int r, float (&kk)[8]) {
    float fp[8]; ld8bf(c.proj + (size_t)row * NIN + C_HF + 64 * h + 8 * q, fp);
#pragma unroll
    for (int i = 0; i < 8; ++i) { const float lb = hg_lb(a, c.l, 64 * h + 8 * q + i);
        const float e = __expf(-fabsf(fp[i]));
        const float sp = fp[i] >= 0.f ? 1.0f / (1.0f + e) : e / (1.0f + e);
        const float sn = fp[i] >= 0.f ? e / (1.0f + e) : 1.0f / (1.0f + e);
        const float lsig = (fp[i] >= 0.f ? 0.f : fp[i]) - log1pf(e);
        const float lf = (lb == 0.f) ? lsig : __logf(lb + (1.0f - lb) * sp);
        LF[r * 65 + 8 * q + i] = lf; kk[i] = (1.0f - lb) * sn; }
}
__device__ __forceinline__ void hg_cumsum(LAS float* LF, int tid) {
    if (tid < 64) { float run = 0.f; for (int m = 0; m < 64; ++m) { run += LF[m * 65 + tid]; LF[m * 65 + tid] = run; } }
}

__device__ __forceinline__ void hg_m1(const Args& a, const MixCtx& c, int b, int ck_, int h) {
    LAS bf16_t* kbT = (LAS bf16_t*)c.lds; LAS bf16_t* vT = (LAS bf16_t*)(c.lds + TILE_B); LAS float* LF = (LAS float*)(c.lds + 6 * TILE_B);
    const int row0 = b * SEQ + 64 * ck_, r = c.tid >> 3, q = c.tid & 7; float kk[8];
    hg_fk(a, c, row0 + r, h, q, LF, r, kk);
    store_vT(c, vT, row0, C_HI + 64 * h);
    __syncthreads();
    hg_cumsum(LF, c.tid);
    __syncthreads();
    if (c.tid < 64) ((float*)(c.ws + WS_HGDEC))[(size_t)((b * NCH + ck_) * 4 + h) * 64 + c.tid] = __expf(LF[63 * 65 + c.tid]);
#pragma unroll
    for (int i = 0; i < 8; ++i) { const int d = 8 * q + i; kbT[d * LD + r] = (bf16_t)f2bf(kk[i] * __expf(LF[63 * 65 + d] - LF[r * 65 + d])); }
    __syncthreads();
    f32x4 acc[2] = {(f32x4){0.f, 0.f, 0.f, 0.f}, (f32x4){0.f, 0.f, 0.f, 0.f}};
    mm64(acc, vT, kbT, c.wave, c.lane);
    store_state(acc, (float*)(c.ws + WS_SHG) + (size_t)((b * NCH + ck_) * 4 + h) * 4096, c.wave, c.lane);
    __syncthreads();
}

template <int KIND>
__device__ __forceinline__ void mix_m3(const Args& a, const MixCtx& c, int b, int ck_, int h) {
    const int tid = c.tid, lane = c.lane, wave = c.wave;
    LAS bf16_t* qr = (LAS bf16_t*)c.lds; LAS bf16_t* kr = (LAS bf16_t*)(c.lds + TILE_B); LAS bf16_t* qd = (LAS bf16_t*)(c.lds + 2 * TILE_B);
    LAS bf16_t* vT = (LAS bf16_t*)(c.lds + 3 * TILE_B); LAS bf16_t* ST = (LAS bf16_t*)(c.lds + 4 * TILE_B); LAS bf16_t* Pm = (LAS bf16_t*)(c.lds + 5 * TILE_B);
    LAS float* LF = (LAS float*)(c.lds + 6 * TILE_B);
    LAS float* OB = (LAS float*)(c.lds + 6 * TILE_B + 16640);
    const int row0 = b * SEQ + 64 * ck_;
    const float lg = ret_lg(h);
    const float* Sg = (const float*)(c.ws + (KIND == 0 ? WS_SRET : WS_SHG)) + (size_t)((b * NCH + ck_) * 4 + h) * 4096;
    { const int e = tid >> 3, q = tid & 7; const f32x4 s0 = *(const f32x4*)(Sg + e * 64 + 8 * q), s1 = *(const f32x4*)(Sg + e * 64 + 8 * q + 4);
      u32x4 w; w.x = pk2(s0[0], s0[1]); w.y = pk2(s0[2], s0[3]); w.z = pk2(s1[0], s1[1]); w.w = pk2(s1[2], s1[3]); *(LAS u32x4*)(ST + e * LD + 8 * q) = w; }
    store_vT(c, vT, row0, (KIND == 0 ? C_RV : C_HI) + 64 * h);
    if (KIND == 0) {
        const int half = tid >> 8, r = (tid & 255) >> 2, cp = tid & 3; float o1[8], o2[8];
        rot8(c, c.proj + (size_t)(row0 + r) * NIN + (half ? C_RK : C_RQ) + 64 * h, 64 * ck_ + r, cp, o1, o2);
        if (half == 0) {
            *(LAS u32x4*)(qr + r * LD + 8 * cp) = pack8(o1); *(LAS u32x4*)(qr + r * LD + 32 + 8 * cp) = pack8(o2);
            const float sc = __expf((float)(r + 1) * lg);
#pragma unroll
            for (int i = 0; i < 8; ++i) { o1[i] *= sc; o2[i] *= sc; }
            *(LAS u32x4*)(qd + r * LD + 8 * cp) = pack8(o1); *(LAS u32x4*)(qd + r * LD + 32 + 8 * cp) = pack8(o2);
        } else {
#pragma unroll
            for (int i = 0; i < 8; ++i) { o1[i] *= 0.125f; o2[i] *= 0.125f; }
            *(LAS u32x4*)(kr + r * LD + 8 * cp) = pack8(o1); *(LAS u32x4*)(kr + r * LD + 32 + 8 * cp) = pack8(o2);
        }
    } else {
        const int r = tid >> 3, q = tid & 7; float kk[8], qv[8];
        hg_fk(a, c, row0 + r, h, q, LF, r, kk);
        ld8bf(c.proj + (size_t)(row0 + r) * NIN + C_HQ + 64 * h + 8 * q, qv);
#pragma unroll
        for (int i = 0; i < 8; ++i) qv[i] = qv[i] * sigmoidf_(qv[i]);
        __syncthreads();
        hg_cumsum(LF, tid);
        __syncthreads();
        float a1[8], a2[8], a3[8];
#pragma unroll
        for (int i = 0; i < 8; ++i) { const int d = 8 * q + i; const float bn = LF[r * 65 + d], rf = LF[31 * 65 + d];
            a1[i] = qv[i] * __expf(bn - rf); a2[i] = kk[i] * __expf(rf - bn); a3[i] = qv[i] * __expf(bn); }
        *(LAS u32x4*)(qr + r * LD + 8 * q) = pack8(a1); *(LAS u32x4*)(kr + r * LD + 8 * q) = pack8(a2); *(LAS u32x4*)(qd + r * LD + 8 * q) = pack8(a3);
    }
    __syncthreads();
    const int rb = wave >> 1, cb0 = (wave & 1) * 2, fr = lane & 15, fq = lane >> 4;
    {
        f32x4 sc[2] = {(f32x4){0.f, 0.f, 0.f, 0.f}, (f32x4){0.f, 0.f, 0.f, 0.f}};
        mm64(sc, qr, kr, wave, lane);
#pragma unroll
        for (int t = 0; t < 2; ++t)
#pragma unroll
            for (int r = 0; r < 4; ++r) { const int n = 16 * rb + 4 * fq + r, m = 16 * (cb0 + t) + fr; float v = sc[t][r];
                if (KIND == 0) v *= __expf((float)(n - m) * lg);
                v = (m <= n) ? v : 0.f;
                Pm[n * LD + m] = (bf16_t)f2bf(v); }
    }
    __syncthreads();
    {
        f32x4 o[2] = {(f32x4){0.f, 0.f, 0.f, 0.f}, (f32x4){0.f, 0.f, 0.f, 0.f}};
        mm64(o, Pm, vT, wave, lane);
        mm64(o, qd, ST, wave, lane);
#pragma unroll
        for (int t = 0; t < 2; ++t)
#pragma unroll
            for (int r = 0; r < 4; ++r) OB[(16 * rb + 4 * fq + r) * 68 + 16 * (cb0 + t) + fr] = o[t][r];
    }
    __syncthreads();
    {
        const int n = tid >> 3, q = tid & 7, row = row0 + n; float v[8], g[8]; float ss = 0.f;
#pragma unroll
        for (int i = 0; i < 8; ++i) { v[i] = OB[n * 68 + 8 * q + i]; ss += v[i] * v[i]; }
        ss += __shfl_xor(ss, 1); ss += __shfl_xor(ss, 2); ss += __shfl_xor(ss, 4);
        const float rs = rsqrtf(ss * (1.0f / 64.0f) + EPS);
        ld8bf(c.proj + (size_t)row * NIN + (KIND == 0 ? C_RG : C_HG) + 64 * h + 8 * q, g);
        const float* nw = a.in[KIND == 0 ? I_RNW : I_HNW] + c.l * 256 + 64 * h + 8 * q;
#pragma unroll
        for (int i = 0; i < 8; ++i) v[i] = v[i] * rs * nw[i] * (g[i] * sigmoidf_(g[i]));
        *(u32x4*)(c.y + (size_t)row * DM + (KIND == 0 ? 512 : 768) + 64 * h + 8 * q) = pack8(v);
    }
    __syncthreads();
}

__device__ __forceinline__ void mix_phase(const Args& a, const MixCtx& c, int pass) {
    for (int su = blockIdx.x; su < BATCH * NCH * 16; su += gridDim.x) {
        const int bc = su >> 4, k = ((su & 15) + (su >> 8)) & 15, b = bc / NCH, ck_ = bc % NCH;
        if (pass == 1) { if (k < 8) lru_m1(a, c, b, ck_, k); else if (k < 12) ret_m1(c, b, ck_, k - 8); else hg_m1(a, c, b, ck_, k - 12); }
        else { if (k < 8) lru_m3(c, b, ck_, k); else if (k < 12) mix_m3<0>(a, c, b, ck_, k - 8); else mix_m3<1>(a, c, b, ck_, k - 12); }
    }
}

__device__ __forceinline__ void mix_m2(const MixCtx& c) {
    const int gt = blockIdx.x * NTHREADS + c.tid, NT = gridDim.x * NTHREADS;
    for (int idx = gt; idx < 2 * 65536; idx += NT) {
        const int kind = idx >> 16, e = idx & 65535, b = e >> 14, h = (e >> 12) & 3, ed = e & 4095;
        float* S = (float*)(c.ws + (kind == 0 ? WS_SRET : WS_SHG)) + (size_t)(b * NCH * 4 + h) * 4096 + ed;
        float s = 0.f;
        if (kind == 0) { const float dec = __expf(64.0f * ret_lg(h));
#pragma unroll 8
            for (int ck_ = 0; ck_ < NCH; ++ck_) { const float kv = S[(size_t)ck_ * 16384]; S[(size_t)ck_ * 16384] = s; s = s * dec + kv; }
        } else { const float* dp = (const float*)(c.ws + WS_HGDEC) + (size_t)(b * NCH * 4 + h) * 64 + (ed & 63);
#pragma unroll 8
            for (int ck_ = 0; ck_ < NCH; ++ck_) { const float kv = S[(size_t)ck_ * 16384]; const float dec = dp[ck_ * 256]; S[(size_t)ck_ * 16384] = s; s = s * dec + kv; }
        }
    }
    for (int idx = gt; idx < BATCH * 512; idx += NT) { const int b = idx >> 9, ch = idx & 511;
        const float* A = (const float*)(c.ws + WS_LRUA) + (size_t)b * NCH * 512 + ch; const float* H = (const float*)(c.ws + WS_LRUH) + (size_t)b * NCH * 512 + ch;
        float* HI = (float*)(c.ws + WS_LRUIN) + (size_t)b * NCH * 512 + ch; float hh = 0.f;
#pragma unroll 8
        for (int ck_ = 0; ck_ < NCH; ++ck_) { const float av = A[ck_ * 512], hv = H[ck_ * 512]; HI[ck_ * 512] = hh; hh = av * hh + hv; } }
}

__device__ __forceinline__ void final_norm(const Args& a, int tid) {
    const int lane = tid & 63, gw = blockIdx.x * 8 + (tid >> 6), NGW = gridDim.x * 8;
    const float* ssq = (const float*)(a.ws + WS_SSQ); const f32x4* fw = (const f32x4*)a.in[I_FNW] + lane;
    for (int m = gw; m < MROWS; m += NGW) { const float rs = rstd_of(ssq, m); f32x4* xr = (f32x4*)(a.out + (size_t)m * DM) + lane;
#pragma unroll
        for (int j = 0; j < 4; ++j) { f32x4 v = xr[64 * j]; const f32x4 w = fw[64 * j]; v = v * rs * w; xr[64 * j] = v; } }
}

#ifdef OFF_P0
#define ON_P0(...)
#else
#define ON_P0(...) __VA_ARGS__
#endif
#ifdef OFF_FN
#define ON_FN(...)
#else
#define ON_FN(...) __VA_ARGS__
#endif
#ifdef OFF_G1
#define ON_G1(...)
#else
#define ON_G1(...) __VA_ARGS__
#endif
#ifdef OFF_M2
#define ON_M2(...)
#else
#define ON_M2(...) __VA_ARGS__
#endif
#ifdef OFF_MX
#define ON_MX(...)
#else
#define ON_MX(...) __VA_ARGS__
#endif
#ifdef OFF_G2
#define ON_G2(...)
#else
#define ON_G2(...) __VA_ARGS__
#endif
#ifdef OFF_G3
#define ON_G3(...)
#else
#define ON_G3(...) __VA_ARGS__
#endif
#ifdef OFF_G4
#define ON_G4(...)
#else
#define ON_G4(...) __VA_ARGS__
#endif
constexpr int N_PHASES = 16;
__global__ void __launch_bounds__(NTHREADS, 2) fwd_kernel(Args a) {
    extern __shared__ __attribute__((aligned(16))) unsigned char lds_raw[];
    LAS unsigned char* lds = (LAS unsigned char*)lds_raw;
    unsigned char* ws = a.ws;
    bf16_t* xb = (bf16_t*)(ws + WS_XB); bf16_t* r1 = (bf16_t*)(ws + WS_R1); bf16_t* yb = (bf16_t*)(ws + WS_Y); float* ssq = (float*)(ws + WS_SSQ);
    for (int ph = a.ph_lo; ph < a.ph_hi; ++ph) {
        int tid = threadIdx.x; asm volatile("" : "+v"(tid));
        if (ph == 0) { ON_P0(p0_prologue(a, lds, tid);) }
        else if (ph == N_PHASES - 1) { ON_FN(final_norm(a, tid);) }
        else {
            const int l = (ph - 1) / 7, k = (ph - 1) % 7;
            if (k == 0) {
                pg8::Gemm g{xb, (const bf16_t*)(ws + WS_WIN) + (size_t)l * NIN * DM, DM}; pg8::StaticOrder S; S.init(MROWS / 256, NIN / 256, gridDim.x, blockIdx.x);
                pg8::EpiProj E{r1, ssq}; ON_G1(pg8::gemm_phase<pg8::EpiProj, false>(lds, g, S, E, tid);)
            } else if (k >= 1 && k <= 3) {
                MixCtx c; c.l = l; c.ws = ws; c.lds = lds; c.tid = tid; c.lane = tid & 63; c.wave = tid >> 6; c.proj = r1; c.y = yb;
                if (k == 2) { ON_M2(mix_m2(c);) } else { ON_MX(mix_phase(a, c, k);) }
            } else if (k == 4) {
                pg8::Gemm g{yb, (const bf16_t*)(ws + WS_WOUT) + (size_t)l * DM * DM, DM}; pg8::StaticOrder S; S.init(MROWS / 256, DM / 256, gridDim.x, blockIdx.x);
                pg8::EpiResid E{l == 0 ? a.in[I_X] : a.out, a.out, xb, ssq}; ON_G2(pg8::gemm_phase<pg8::EpiResid, false>(lds, g, S, E, tid);)
            } else if (k == 5) {
                pg8::Gemm g{xb, (const bf16_t*)(ws + WS_WUP) + (size_t)l * NUP * DM, DM}; pg8::StaticOrder S; S.init(BATCH * UPU, NUP / 256, gridDim.x, blockIdx.x);
                pg8::EpiFfn E{r1, ssq, a.in[I_FCW] + (size_t)l * 3 * NUP, a.in[I_FCB] + (size_t)l * NUP}; ON_G3(pg8::gemm_phase<pg8::EpiFfn, true>(lds, g, S, E, tid);)
            } else {
                pg8::Gemm g{r1, (const bf16_t*)(ws + WS_WDN) + (size_t)l * DM * DFF, DFF}; pg8::StaticOrder S; S.init(MROWS / 256, DM / 256, gridDim.x, blockIdx.x);
                pg8::EpiResid E{a.out, a.out, xb, ssq}; ON_G4(pg8::gemm_phase<pg8::EpiResid, false>(lds, g, S, E, tid);)
            }
        }
        if (ph + 1 < a.ph_hi) { __syncthreads(); cg::this_grid().sync(); }
    }
}

extern "C" void kernel_launch(void* const* d_in, const int* in_sizes, int n_in, void* d_out, int out_size, void* d_ws, size_t ws_size, hipStream_t stream) {
    static int grid = 0;
    if (grid == 0) {
        if (n_in != 20 || in_sizes[0] != MROWS * DM || out_size != MROWS * DM || ws_size < WS_END) {
            fprintf(stderr, "kernel_launch: unexpected problem: n_in %d in0 %d out %d ws %zu (need %zu)\n", n_in, n_in > 0 ? in_sizes[0] : -1, out_size, ws_size, (size_t)WS_END); grid = -1; return; }
        int dev = 0, cus = 0, per_cu = 0;
        (void)hipGetDevice(&dev); (void)hipDeviceGetAttribute(&cus, hipDeviceAttributeMultiprocessorCount, dev);
        if (hipFuncSetAttribute((const void*)fwd_kernel, hipFuncAttributeMaxDynamicSharedMemorySize, LDS_BYTES) != hipSuccess) { fprintf(stderr, "kernel_launch: hipFuncSetAttribute failed\n"); grid = -1; return; }
        if (hipOccupancyMaxActiveBlocksPerMultiprocessor(&per_cu, (const void*)fwd_kernel, NTHREADS, LDS_BYTES) != hipSuccess || per_cu < 1) { fprintf(stderr, "kernel_launch: occupancy query says %d\n", per_cu); per_cu = 1; }
        (void)hipGetLastError();
        grid = cus > 0 ? cus : 256;
    }
    if (grid < 0) return;
    Args a{};
    for (int i = 0; i < 20; ++i) a.in[i] = (const float*)d_in[i];
    a.out = (float*)d_out; a.ws = (unsigned char*)d_ws;
#if MK_ONE_LAUNCH
    a.ph_lo = 0; a.ph_hi = N_PHASES;
    void* args[] = {&a};
    hipError_t e = hipLaunchCooperativeKernel((const void*)fwd_kernel, dim3(grid), dim3(NTHREADS), args, LDS_BYTES, stream);
    if (e != hipSuccess) fprintf(stderr, "kernel_launch: cooperative launch failed: %s (grid %d)\n", hipGetErrorString(e), grid);
#else
    for (int ph = 0; ph < N_PHASES; ++ph) { a.ph_lo = ph; a.ph_hi = ph + 1; hipLaunchKernelGGL(fwd_kernel, dim3(grid), dim3(NTHREADS), LDS_BYTES, stream, a); }
#endif
}
```

```cpp
#include <hip/hip_runtime.h>
#include <hip/hip_cooperative_groups.h>
#include <cstdio>
#include <cstdint>
namespace cg = cooperative_groups;

#ifndef MK_ONE_LAUNCH
#define MK_ONE_LAUNCH 1
#endif

#define LAS __attribute__((address_space(3)))
typedef unsigned short bf16_t;
typedef short bf16x8 __attribute__((ext_vector_type(8)));
typedef float f32x4 __attribute__((ext_vector_type(4)));
typedef unsigned u32x4 __attribute__((ext_vector_type(4)));

constexpr int BATCH = 4, SEQ = 8192, DM = 1024, MROWS = BATCH * SEQ;
constexpr int NIN = 3072, DFF = 2816, NUP = 2 * DFF;
constexpr int NCH = SEQ / 64;
constexpr float EPS = 1e-6f;
constexpr int C_LX = 0, C_LG = 512, C_RQ = 1024, C_RK = 1280, C_RV = 1536, C_RG = 1792, C_HQ = 2048, C_HF = 2304, C_HI = 2560, C_HG = 2816;
__host__ __device__ constexpr int CL(int h, int t) { return 128 * h + 64 * t; }
__host__ __device__ constexpr int CR(int h, int t) { return 1024 + 256 * h + 64 * t; }
__host__ __device__ constexpr int CH(int h, int t) { return 2048 + 256 * h + 64 * t; }
__host__ __device__ constexpr int proj_col_of(int n) {
    if (n < 1024) return 128 * ((n & 511) >> 6) + 64 * (n >> 9) + (n & 63);
    const int base = n < 2048 ? 1024 : 2048, r = n - base; return base + 256 * ((r & 255) >> 6) + 64 * (r >> 8) + (r & 63);
}
constexpr int UPU = 33;

constexpr size_t MiB = 1u << 20;
constexpr size_t WS_WIN = 1 * MiB;
constexpr size_t WS_WOUT = 13 * MiB;
constexpr size_t WS_WUP = 17 * MiB;
constexpr size_t WS_WDN = 39 * MiB;
constexpr size_t WS_GATE = 50 * MiB;
constexpr size_t WS_ROPE = 51 * MiB;
constexpr size_t WS_SSQ = 53 * MiB;
constexpr size_t WS_LRUA = 55 * MiB;
constexpr size_t WS_LRUH = 56 * MiB;
constexpr size_t WS_LRUIN = 57 * MiB;
constexpr size_t WS_HGDEC = 58 * MiB;
constexpr size_t WS_XB = 64 * MiB;
constexpr size_t WS_R1 = 128 * MiB;
constexpr size_t WS_Y = 320 * MiB;
constexpr size_t WS_P = 384 * MiB;
constexpr size_t WS_SRET = 448 * MiB;
constexpr size_t WS_SHG = 464 * MiB;
constexpr size_t WS_END = 480 * MiB;

constexpr int LDS_PHASE = 147456;
constexpr int LDS_BYTES = LDS_PHASE + 256;
constexpr int NTHREADS = 512;

typedef float f32x2_t __attribute__((ext_vector_type(2)));
typedef __bf16 bf16x2_t __attribute__((ext_vector_type(2)));
__device__ __forceinline__ unsigned pk2(float lo, float hi) { const f32x2_t v = {lo, hi}; const bf16x2_t b = __builtin_convertvector(v, bf16x2_t); return __builtin_bit_cast(unsigned, b); }
__device__ __forceinline__ unsigned f2bf(float f) { return pk2(f, f) & 0xffffu; }
__device__ __forceinline__ u32x4 pack8(const float (&v)[8]) { u32x4 w; w.x = pk2(v[0], v[1]); w.y = pk2(v[2], v[3]); w.z = pk2(v[4], v[5]); w.w = pk2(v[6], v[7]); return w; }
__device__ __forceinline__ void unpack8(u32x4 w, float (&o)[8]) {
    o[0] = __uint_as_float(w.x << 16); o[1] = __uint_as_float(w.x & 0xffff0000u); o[2] = __uint_as_float(w.y << 16); o[3] = __uint_as_float(w.y & 0xffff0000u);
    o[4] = __uint_as_float(w.z << 16); o[5] = __uint_as_float(w.z & 0xffff0000u); o[6] = __uint_as_float(w.w << 16); o[7] = __uint_as_float(w.w & 0xffff0000u);
}
__device__ __forceinline__ void ld8bf(const bf16_t* p, float (&o)[8]) { unpack8(*(const u32x4*)p, o); }
__device__ __forceinline__ float sigmoidf_(float x) { return __builtin_amdgcn_rcpf(1.0f + __expf(-x)); }
template <int N> __device__ __forceinline__ float dpp_ror(float v) { return __builtin_bit_cast(float, __builtin_amdgcn_update_dpp(0, __builtin_bit_cast(int, v), 0x120 + N, 0xf, 0xf, false)); }
__device__ __forceinline__ float gelu_tanh(float x) { const float z = 0.7978845608028654f * (x + 0.044715f * x * x * x); const float t = 1.0f - 2.0f * __builtin_amdgcn_rcpf(__expf(2.0f * z) + 1.0f); return 0.5f * x * (1.0f + t); }
__device__ __forceinline__ float bperm_f(int src_lane, float v) { return __builtin_bit_cast(float, __builtin_amdgcn_ds_bpermute(src_lane << 2, __builtin_bit_cast(int, v))); }
__device__ __forceinline__ float rstd_q(const float* ssq, int row, int fr, int fq) {
    const f32x4 p = *(const f32x4*)(ssq + (size_t)row * 16 + 4 * fq);
    float s = (p[0] + p[1]) + (p[2] + p[3]);
    const int ln = (fq << 4) | fr; s += bperm_f(ln ^ 16, s); s += bperm_f(ln ^ 32, s);
    return rsqrtf(s * (1.0f / DM) + EPS);
}
__device__ __forceinline__ float rstd_of(const float* ssq, int row) {
    const f32x4* p = (const f32x4*)(ssq + (size_t)row * 16);
    const f32x4 a = p[0], b = p[1], c = p[2], d = p[3];
    const float s = ((a[0] + a[1]) + (a[2] + a[3])) + ((b[0] + b[1]) + (b[2] + b[3])) + ((c[0] + c[1]) + (c[2] + c[3])) + ((d[0] + d[1]) + (d[2] + d[3]));
    return rsqrtf(s * (1.0f / DM) + EPS);
}
#define LDS_WAIT() asm volatile("s_waitcnt lgkmcnt(0)" ::: "memory")

namespace pg8 {
#define PG8_LAS __attribute__((address_space(3)))
constexpr int BM = 256, BK = 64, HALF = 128, HTB = HALF * BK * 2, NXCD = 8, WGM = 8;
__host__ __device__ __forceinline__ int lds_byte(int r, int c) { const int st = (r >> 4) * 2 + (c >> 5), rr = r & 15, cc = c & 31, ob = rr * 64 + cc * 2; return st * 1024 + (ob ^ (((ob >> 9) & 1) << 5)); }
__host__ __device__ __forceinline__ void stage_rc(int b, int& R, int& C) { const int st = b / 1024, sb = b % 1024, swz = sb ^ (((sb >> 9) & 1) << 5); R = (st >> 1) * 16 + swz / 64; C = (st & 1) * 32 + (swz % 64) / 2; }
__host__ __device__ __forceinline__ int perm32(int rho) { const int n = rho >> 4, i = rho & 15; return 8 * (i >> 2) + 4 * n + (i & 3); }

struct Unit { int pm, pn; };
struct Gemm { const bf16_t* A; const bf16_t* Bt; int K; };

struct StaticOrder {
    int nM, nN, nwg, G, c;
    __host__ __device__ void init(int nM_, int nN_, int G_, int c_) { nM = nM_; nN = nN_; nwg = nM * nN; G = G_; c = c_; }
    __host__ __device__ bool next(int i, Unit& u) const {
        const long L = (long)i * G + c; if (L >= nwg) return false;
        int wgid = (int)L; { const int q = nwg / NXCD, r = nwg % NXCD, xcd = wgid % NXCD, off = wgid / NXCD; wgid = (xcd < r ? xcd * (q + 1) : r * (q + 1) + (xcd - r) * q) + off; }
        const int nig = WGM * nN, gid = wgid / nig, fm = gid * WGM, gsz = (nM - fm) < WGM ? (nM - fm) : WGM;
        u.pm = fm + ((wgid % nig) % gsz); u.pn = (wgid % nig) / gsz; return true;
    }
};

template <bool HALO> __device__ __forceinline__ size_t a_unit_off(int pm, int K) {
    if (HALO) return ((size_t)(pm / UPU) * SEQ + (size_t)(pm % UPU) * 252) * (size_t)K * 2;
    return (size_t)pm * 256 * (size_t)K * 2;
}

template <class Epi, bool HALO>
__device__ __forceinline__ void gemm_phase(PG8_LAS unsigned char* lds, const Gemm g, const StaticOrder& S, const Epi& E, const int tid) {
    const int wid = __builtin_amdgcn_readfirstlane(tid >> 6), lane = tid & 63, wr = wid >> 2, wc = wid & 3, fr = lane & 15, fq = lane >> 4;
    const int K = g.K, nt = K / BK;
    int voffA[2], voffB[2];
#pragma unroll
    for (int i = 0; i < 2; ++i) { int R, C; stage_rc(tid * 16 + i * 8192, R, C); const int Rb = (R & ~31) + perm32(R & 31);
        const int Ra = HALO ? (126 * (R >> 6) - 2 + (R & 63)) : R;
        voffA[i] = (Ra * K + C) * 2; voffB[i] = (Rb * K + C) * 2; }
    const size_t kstep = (size_t)(BK * 2);
    const size_t hstepB = (size_t)HALF * K * 2;
    const size_t hstepA = HALO ? (size_t)64 * K * 2 : (size_t)HALF * K * 2;
    const size_t tstepB = 2 * hstepB;
    const unsigned ldsw = (unsigned)wid * 1024u;
    const int aoff = lds_byte(wr * 64 + fr, fq * 8), boff = lds_byte(wc * 32 + fr, fq * 8);
#define PG8_SA(b, h) (((b) * 2 + (h)) * HTB)
#define PG8_SB(b, h) ((4 + (b) * 2 + (h)) * HTB)
#define PG8_STAGE(bufoff, gbase, voff) do { _Pragma("unroll") for (int _i = 0; _i < 2; ++_i) \
        __builtin_amdgcn_global_load_lds((const unsigned*)((const char*)(gbase) + (voff)[_i]), (PG8_LAS unsigned*)(lds + (bufoff) + ldsw + _i * 8192), 16, 0, 0); } while (0)
#define PG8_LDA(dst, b, h) do { _Pragma("unroll") for (int m = 0; m < 4; ++m) _Pragma("unroll") for (int k = 0; k < 2; ++k) dst[m][k] = *(const PG8_LAS bf16x8*)(lds + PG8_SA(b, h) + aoff + m * 2048 + k * 1024); } while (0)
#define PG8_LDB(dst, b, h) do { _Pragma("unroll") for (int n = 0; n < 2; ++n) _Pragma("unroll") for (int k = 0; k < 2; ++k) dst[n][k] = *(const PG8_LAS bf16x8*)(lds + PG8_SB(b, h) + boff + n * 2048 + k * 1024); } while (0)
#define PG8_MMA(ai, bj, At, Bt) do { __builtin_amdgcn_s_setprio(1); _Pragma("unroll") for (int m = 0; m < 4; ++m) _Pragma("unroll") for (int n = 0; n < 2; ++n) _Pragma("unroll") for (int k = 0; k < 2; ++k) \
        acc[ai][bj][m][n] = __builtin_amdgcn_mfma_f32_16x16x32_bf16(Bt[n][k], At[m][k], acc[ai][bj][m][n], 0, 0, 0); __builtin_amdgcn_s_setprio(0); } while (0)
#define PG8_WAIT_V(n) asm volatile("s_waitcnt vmcnt(" #n ")" ::: "memory")
#define PG8_WAIT_L(n) asm volatile("s_waitcnt lgkmcnt(" #n ")" ::: "memory")
#define PG8_BAR __builtin_amdgcn_s_barrier()
#define PG8_SCHED __builtin_amdgcn_sched_barrier(0)
    Unit cur, nxt; int ui = 0;
    if (!S.next(0, cur)) return;
    f32x4 acc[2][2][4][2];
#pragma unroll
    for (int a = 0; a < 2; ++a)
#pragma unroll
        for (int b = 0; b < 2; ++b)
#pragma unroll
            for (int m = 0; m < 4; ++m)
#pragma unroll
                for (int n = 0; n < 2; ++n) acc[a][b][m][n] = (f32x4){0.f, 0.f, 0.f, 0.f};
    bf16x8 At[4][2], B0[2][2], B1[2][2];
    const char* cA = (const char*)g.A + a_unit_off<HALO>(cur.pm, K); const char* cB = (const char*)g.Bt + (size_t)cur.pn * tstepB;
    PG8_STAGE(PG8_SB(0, 0), cB, voffB); PG8_STAGE(PG8_SB(0, 1), cB + hstepB, voffB); PG8_STAGE(PG8_SA(0, 0), cA, voffA); PG8_STAGE(PG8_SA(0, 1), cA + hstepA, voffA);
    if (wr == 1) PG8_BAR;
    PG8_WAIT_V(2); PG8_BAR;
    PG8_STAGE(PG8_SB(1, 0), cB + kstep, voffB); PG8_STAGE(PG8_SA(1, 0), cA + kstep, voffA); PG8_STAGE(PG8_SB(1, 1), cB + hstepB + kstep, voffB);
    PG8_WAIT_V(6); PG8_BAR;
    for (;;) {
        const bool has_next = S.next(ui + 1, nxt);
        const char* nA = has_next ? (const char*)g.A + a_unit_off<HALO>(nxt.pm, K) : cA; const char* nB = has_next ? (const char*)g.Bt + (size_t)nxt.pn * tstepB : cB;
        for (int t = 0; t < nt; t += 2) {
            const bool last = (t == nt - 2);
            const char* a1 = cA + (size_t)(t + 1) * kstep;
            const char* a2 = last ? nA : cA + (size_t)(t + 2) * kstep; const char* b2 = last ? nB : cB + (size_t)(t + 2) * kstep;
            const char* a3 = a2 + kstep; const char* b3 = b2 + kstep;
            PG8_LDB(B0, 0, 0); PG8_LDB(B1, 0, 1); PG8_SCHED; PG8_LDA(At, 0, 0); PG8_STAGE(PG8_SA(1, 1), a1 + hstepA, voffA);
            PG8_WAIT_V(8); PG8_WAIT_L(0); PG8_BAR; PG8_MMA(0, 0, At, B0); PG8_MMA(0, 1, At, B1); PG8_BAR; PG8_SCHED;
            PG8_LDA(At, 0, 1); PG8_STAGE(PG8_SB(0, 0), b2, voffB); PG8_STAGE(PG8_SB(0, 1), b2 + hstepB, voffB); PG8_STAGE(PG8_SA(0, 0), a2, voffA);
            PG8_WAIT_V(8); PG8_WAIT_L(0); PG8_BAR; PG8_MMA(1, 0, At, B0); PG8_MMA(1, 1, At, B1); PG8_BAR; PG8_SCHED;
            PG8_LDB(B0, 1, 0); PG8_LDB(B1, 1, 1); PG8_SCHED; PG8_LDA(At, 1, 0); PG8_STAGE(PG8_SA(0, 1), a2 + hstepA, voffA);
            PG8_WAIT_V(8); PG8_WAIT_L(0); PG8_BAR; PG8_MMA(0, 0, At, B0); PG8_MMA(0, 1, At, B1); PG8_BAR; PG8_SCHED;
            PG8_LDA(At, 1, 1); PG8_STAGE(PG8_SB(1, 0), b3, voffB); PG8_STAGE(PG8_SB(1, 1), b3 + hstepB, voffB); PG8_STAGE(PG8_SA(1, 0), a3, voffA);
            PG8_WAIT_V(8); PG8_WAIT_L(0); PG8_BAR; PG8_MMA(1, 0, At, B0); PG8_MMA(1, 1, At, B1); PG8_BAR; PG8_SCHED;
        }
        if (wr == 0) PG8_BAR;
        E(acc, cur, wr, wc, fr, fq);
        if (!has_next) break;
#pragma unroll
        for (int a = 0; a < 2; ++a)
#pragma unroll
            for (int b = 0; b < 2; ++b)
#pragma unroll
                for (int m = 0; m < 4; ++m)
#pragma unroll
                    for (int n = 0; n < 2; ++n) acc[a][b][m][n] = (f32x4){0.f, 0.f, 0.f, 0.f};
        cur = nxt; cA = nA; cB = nB; ++ui;
        if (wr == 1) PG8_BAR;
    }
    PG8_WAIT_V(0);
    PG8_BAR;
#undef PG8_SA
#undef PG8_SB
#undef PG8_STAGE
#undef PG8_LDA
#undef PG8_LDB
#undef PG8_MMA
#undef PG8_WAIT_V
#undef PG8_WAIT_L
#undef PG8_BAR
#undef PG8_SCHED
}

typedef f32x4 Acc[2][2][4][2];

struct EpiProj {
    bf16_t* O; const float* ssq;
    __device__ __forceinline__ void operator()(Acc& acc, const Unit& u, int wr, int wc, int fr, int fq) const {
        const int row0 = u.pm * 256 + wr * 64 + fr, col0 = u.pn * 256 + wc * 32 + 8 * fq, ln = (fq << 4) | fr;
        f32x4 pq[8];
#pragma unroll
        for (int q = 0; q < 8; ++q) pq[q] = *(const f32x4*)(ssq + (size_t)(row0 + (q >> 2) * 128 + (q & 3) * 16) * 16 + 4 * fq);
#pragma unroll
        for (int ai = 0; ai < 2; ++ai)
#pragma unroll
            for (int m = 0; m < 4; ++m) {
                const int row = row0 + ai * 128 + m * 16; const f32x4 p = pq[ai * 4 + m];
                float sq = (p[0] + p[1]) + (p[2] + p[3]); sq += bperm_f(ln ^ 16, sq); sq += bperm_f(ln ^ 32, sq);
                const float rs = rsqrtf(sq * (1.0f / DM) + EPS);
                bf16_t* rowp = O + (size_t)row * NIN + col0;
#pragma unroll
                for (int bj = 0; bj < 2; ++bj) { const f32x4 v0 = acc[ai][bj][m][0] * rs, v1 = acc[ai][bj][m][1] * rs;
                    u32x4 w; w.x = pk2(v0[0], v0[1]); w.y = pk2(v0[2], v0[3]); w.z = pk2(v1[0], v1[1]); w.w = pk2(v1[2], v1[3]);
                    *(u32x4*)(rowp + bj * 128) = w; }
            }
    }
};

struct EpiResid {
    const float* basef; bf16_t* xb; float* ssq;
    __device__ __forceinline__ void operator()(Acc& acc, const Unit& u, int wr, int wc, int fr, int fq) const {
        const int row0 = u.pm * 256 + wr * 64 + fr, col0 = u.pn * 256 + wc * 32 + 8 * fq, ln = (fq << 4) | fr;
#pragma unroll
        for (int ai = 0; ai < 2; ++ai)
#pragma unroll
          for (int mh = 0; mh < 2; ++mh) {
            f32x4 b0[2][2], b1[2][2];
            if (basef) {
#pragma unroll
                for (int mm = 0; mm < 2; ++mm)
#pragma unroll
                    for (int bj = 0; bj < 2; ++bj) { const size_t off = (size_t)(row0 + ai * 128 + (2 * mh + mm) * 16) * DM + col0 + bj * 128; b0[mm][bj] = *(const f32x4*)(basef + off); b1[mm][bj] = *(const f32x4*)(basef + off + 4); }
            } else {
                u32x4 raw[2][2];
#pragma unroll
                for (int mm = 0; mm < 2; ++mm)
#pragma unroll
                    for (int bj = 0; bj < 2; ++bj) raw[mm][bj] = *(const u32x4*)(xb + (size_t)(row0 + ai * 128 + (2 * mh + mm) * 16) * DM + col0 + bj * 128);
#pragma unroll
                for (int mm = 0; mm < 2; ++mm)
#pragma unroll
                    for (int bj = 0; bj < 2; ++bj) { float t[8]; unpack8(raw[mm][bj], t); b0[mm][bj] = (f32x4){t[0], t[1], t[2], t[3]}; b1[mm][bj] = (f32x4){t[4], t[5], t[6], t[7]}; }
            }
#pragma unroll
            for (int mm = 0; mm < 2; ++mm) { const int m = 2 * mh + mm;
                const int row = row0 + ai * 128 + m * 16; float ss = 0.f;
#pragma unroll
                for (int bj = 0; bj < 2; ++bj) { const size_t off = (size_t)row * DM + col0 + bj * 128;
                    const f32x4 v0 = acc[ai][bj][m][0] + b0[mm][bj], v1 = acc[ai][bj][m][1] + b1[mm][bj];
                    u32x4 w; w.x = pk2(v0[0], v0[1]); w.y = pk2(v0[2], v0[3]); w.z = pk2(v1[0], v1[1]); w.w = pk2(v1[2], v1[3]);
                    *(u32x4*)(xb + off) = w;
                    ss += (v0[0] * v0[0] + v0[1] * v0[1]) + (v0[2] * v0[2] + v0[3] * v0[3]) + (v1[0] * v1[0] + v1[1] * v1[1]) + (v1[2] * v1[2] + v1[3] * v1[3]); }
                ss += bperm_f(ln ^ 16, ss); ss += bperm_f(ln ^ 32, ss);
                if (fq == 0) ssq[(size_t)row * 16 + u.pn * 4 + wc] = ss;
            }
          }
    }
};

struct EpiFfn {
    bf16_t* act; const float* ssq; const float* cw; const float* cb;
    __device__ __forceinline__ void operator()(Acc& acc, const Unit& u, int wr, int wc, int fr, int fq) const {
        const int b = u.pm / UPU, j = u.pm % UPU;
        const int tbase = 252 * j + 126 * wr - 2 + fr;
        const int ch0 = 128 * u.pn + 32 * wc + 8 * fq;
        float chain = 0.f;
        { const int ln = (fq << 4) | fr; f32x4 pq[8];
#pragma unroll
          for (int q = 0; q < 8; ++q) { const int t = tbase + 16 * q; const bool ok = (t >= 0) && (t < SEQ); pq[q] = *(const f32x4*)(ssq + (size_t)(b * SEQ + (ok ? t : 0)) * 16 + 4 * fq); }
#pragma unroll
          for (int q = 0; q < 8; ++q) {
            const int t = tbase + 16 * q; const bool ok = (t >= 0) && (t < SEQ);
            float sq = (pq[q][0] + pq[q][1]) + (pq[q][2] + pq[q][3]); sq += bperm_f(ln ^ 16, sq); sq += bperm_f(ln ^ 32, sq);
            const float rs = rsqrtf(sq * (1.0f / DM) + EPS);
#pragma unroll
            for (int bj = 0; bj < 2; ++bj)
#pragma unroll
                for (int n = 0; n < 2; ++n)
#pragma unroll
                    for (int i = 0; i < 4; ++i) { const float v = acc[q >> 2][bj][q & 3][n][i]; acc[q >> 2][bj][q & 3][n][i] = ok ? v * rs : 0.f; }
          }
          __builtin_amdgcn_sched_barrier(0);
        }
#pragma unroll
        for (int n = 0; n < 2; ++n) {
#pragma unroll
            for (int i = 0; i < 4; ++i) {
                const int cg_ = ch0 + 4 * n + i, cv_ = DFF + cg_;
                const float g0 = cw[cg_], g1 = cw[NUP + cg_], g2 = cw[2 * NUP + cg_], gb = cb[cg_];
                const float v0 = cw[cv_], v1 = cw[NUP + cv_], v2 = cw[2 * NUP + cv_], vb = cb[cv_];
                float pg1 = 0.f, pg2 = 0.f, pv1 = 0.f, pv2 = 0.f;
#pragma unroll
                for (int q = 0; q < 8; ++q) {
                    float cgv = acc[q >> 2][0][q & 3][n][i], cvv = acc[q >> 2][1][q & 3][n][i];
                    asm volatile("" : "+v"(cgv), "+v"(cvv) : "v"(chain));
                    const float tg1 = dpp_ror<1>(cgv), tg2 = dpp_ror<2>(cgv), tv1 = dpp_ror<1>(cvv), tv2 = dpp_ror<2>(cvv);
                    const float sg1 = fr >= 1 ? tg1 : pg1, sg2 = fr >= 2 ? tg2 : pg2, sv1 = fr >= 1 ? tv1 : pv1, sv2 = fr >= 2 ? tv2 : pv2;
                    const float gg = gb + g0 * sg2 + g1 * sg1 + g2 * cgv;
                    const float vv = vb + v0 * sv2 + v1 * sv1 + v2 * cvv;
                    chain = gg * sigmoidf_(gg) * vv; acc[q >> 2][0][q & 3][n][i] = chain;
                    pg1 = tg1; pg2 = tg2; pv1 = tv1; pv2 = tv2;
                }
                __builtin_amdgcn_sched_barrier(0);
            }
        }
#pragma unroll
        for (int q = 0; q < 8; ++q) {
            const int t = tbase + 16 * q;
            if ((16 * q + fr >= 2) && (t < SEQ)) {
                const f32x4 a0 = acc[q >> 2][0][q & 3][0], a1 = acc[q >> 2][0][q & 3][1];
                u32x4 w; w.x = pk2(a0[0], a0[1]); w.y = pk2(a0[2], a0[3]); w.z = pk2(a1[0], a1[1]); w.w = pk2(a1[2], a1[3]);
                *(u32x4*)(act + (size_t)(b * SEQ + t) * DFF + ch0) = w;
            }
        }
    }
};
}

struct Args { const float* in[20]; float* out; unsigned char* ws; int ph_lo, ph_hi; };
enum { I_X = 0, I_N1, I_WIN, I_LCW, I_LCB, I_WA, I_BA, I_WX, I_BX, I_LAM, I_RNW, I_HLB, I_HNW, I_WOUT, I_N2, I_WUP, I_FCW, I_FCB, I_WDN, I_FNW };
__device__ __forceinline__ const float* in_ptr(const Args& a, int i) { asm volatile("" : "+s"(i)); return a.in[i]; }

__device__ __forceinline__ void p0_item(const float* W, int K, int N, bf16_t* WT, const float* scale, int rmap  , LAS float* scr, int item, int lane) {
    const int nblk = N / 32, kb = item / nblk, nb = item % nblk, k0 = 64 * kb, n0 = 32 * nb;
    float wv[32];
#pragma unroll
    for (int i = 0; i < 32; ++i) wv[i] = W[(size_t)(k0 + 2 * i + (lane >> 5)) * N + n0 + (lane & 31)];
    if (scale) {
#pragma unroll
        for (int i = 0; i < 32; ++i) wv[i] *= scale[k0 + 2 * i + (lane >> 5)]; }
#pragma unroll
    for (int i = 0; i < 32; ++i) scr[(2 * i + (lane >> 5)) * 33 + (lane & 31)] = wv[i];
    LDS_WAIT();
    const int c = lane & 7;
#pragma unroll
    for (int j = 0; j < 4; ++j) { const int n = (lane >> 3) + 8 * j; const LAS float* s = scr + (8 * c) * 33 + n;
        u32x4 o; o.x = pk2(s[0 * 33], s[1 * 33]); o.y = pk2(s[2 * 33], s[3 * 33]); o.z = pk2(s[4 * 33], s[5 * 33]); o.w = pk2(s[6 * 33], s[7 * 33]);
        int row = n0 + n;
        if (rmap == 1) { const int bj = row >= DFF ? 1 : 0, ch = row - DFF * bj; row = 256 * (ch >> 7) + 128 * bj + (ch & 127); }
        else if (rmap == 2) row = proj_col_of(row);
        *(u32x4*)(WT + (size_t)row * K + k0 + 8 * c) = o; }
    LDS_WAIT();
}

__device__ __forceinline__ void p0_prologue(const Args& a, unsigned char* ws, LAS unsigned char* lds, const int tid) {
    const int lane = tid & 63, wave = tid >> 6;
    const int G = gridDim.x, gw = blockIdx.x * 8 + wave, NGW = G * 8;
    LAS float* scr = (LAS float*)(lds + wave * 16384);
    constexpr int I_IN = 16 * (NIN / 32), I_OUT = 16 * (DM / 32), I_UP = 16 * (NUP / 32), I_DN = (DFF / 64) * (DM / 32);
    constexpr int PER_L = I_IN + I_OUT + I_UP + I_DN;
    for (int it = gw; it < 2 * PER_L; it += NGW) {
        const int l = it / PER_L; int r = it % PER_L;
        if (r < I_IN) { p0_item(in_ptr(a, I_WIN) + (size_t)l * DM * NIN, DM, NIN, (bf16_t*)(ws + WS_WIN) + (size_t)l * NIN * DM, in_ptr(a, I_N1) + l * DM, 2, scr, r, lane); continue; } r -= I_IN;
        if (r < I_OUT) { p0_item(in_ptr(a, I_WOUT) + (size_t)l * DM * DM, DM, DM, (bf16_t*)(ws + WS_WOUT) + (size_t)l * DM * DM, nullptr, 0, scr, r, lane); continue; } r -= I_OUT;
        if (r < I_UP) { p0_item(in_ptr(a, I_WUP) + (size_t)l * DM * NUP, DM, NUP, (bf16_t*)(ws + WS_WUP) + (size_t)l * NUP * DM, in_ptr(a, I_N2) + l * DM, 1, scr, r, lane); continue; } r -= I_UP;
        p0_item(in_ptr(a, I_WDN) + (size_t)l * DFF * DM, DFF, DM, (bf16_t*)(ws + WS_WDN) + (size_t)l * DM * DFF, nullptr, 0, scr, r, lane);
    }
    {
        const float* x = in_ptr(a, I_X); bf16_t* xb = (bf16_t*)(ws + WS_XB); float* ssq = (float*)(ws + WS_SSQ);
        for (int m0 = 2 * gw; m0 < MROWS; m0 += 2 * NGW) {
            f32x4 v[2][4]; float s2[2];
#pragma unroll
            for (int r = 0; r < 2; ++r) { const f32x4* xr = (const f32x4*)(x + (size_t)(m0 + r) * DM) + lane;
#pragma unroll
                for (int j = 0; j < 4; ++j) v[r][j] = xr[64 * j]; }
#pragma unroll
            for (int r = 0; r < 2; ++r) { float s = 0.f;
#pragma unroll
                for (int j = 0; j < 4; ++j) s += (v[r][j][0] * v[r][j][0] + v[r][j][1] * v[r][j][1]) + (v[r][j][2] * v[r][j][2] + v[r][j][3] * v[r][j][3]);
#pragma unroll
                for (int o = 1; o < 64; o <<= 1) s += bperm_f(lane ^ o, s);
                s2[r] = s; }
#pragma unroll
            for (int r = 0; r < 2; ++r) { unsigned long long* o8 = (unsigned long long*)(xb + (size_t)(m0 + r) * DM) + lane;
#pragma unroll
                for (int j = 0; j < 4; ++j) o8[64 * j] = (unsigned long long)pk2(v[r][j][0], v[r][j][1]) | ((unsigned long long)pk2(v[r][j][2], v[r][j][3]) << 32);
                if (lane < 16) ssq[(size_t)(m0 + r) * 16 + lane] = lane == 0 ? s2[r] : 0.f; }
        }
    }
    {
        const int gt = blockIdx.x * NTHREADS + tid, NT = G * NTHREADS;
        float* cosT = (float*)(ws + WS_ROPE); float* sinT = cosT + SEQ * 32;
        for (int idx = gt; idx < SEQ * 32; idx += NT) { const int pos = idx >> 5, i = idx & 31;
            const float inv = powf(10000.0f, -(float)(2 * i) / 64.0f); const float ang = (float)pos * inv; float s, c; sincosf(ang, &s, &c); cosT[idx] = c; sinT[idx] = s; }
        bf16_t* gw_ = (bf16_t*)(ws + WS_GATE);
        const float* wa_ = in_ptr(a, I_WA); const float* wx_ = in_ptr(a, I_WX);
        for (int idx = gt; idx < 2 * 2 * 8 * 4096; idx += NT) { const int i = idx & 63, jj = (idx >> 6) & 63, h = (idx >> 12) & 7, ax = (idx >> 15) & 1, l = idx >> 16;
            const float* src = (ax ? wx_ : wa_) + (size_t)l * 8 * 4096 + h * 4096 + i * 64 + jj; gw_[idx] = (bf16_t)f2bf(*src); }
    }
}

constexpr int LD = 72;
constexpr int TILE_B = 64 * LD * 2;
__device__ __forceinline__ void mm64(f32x4 (&acc)[2], const LAS bf16_t* A, const LAS bf16_t* Bt, int wave, int lane) {
    const int rb = wave >> 1, cb0 = (wave & 1) * 2, fr = lane & 15, fq = lane >> 4;
#pragma unroll
    for (int kk = 0; kk < 2; ++kk) {
        const bf16x8 av = *(const LAS bf16x8*)(A + (16 * rb + fr) * LD + 32 * kk + 8 * fq);
#pragma unroll
        for (int t = 0; t < 2; ++t) {
            const bf16x8 bv = *(const LAS bf16x8*)(Bt + (16 * (cb0 + t) + fr) * LD + 32 * kk + 8 * fq);
            acc[t] = __builtin_amdgcn_mfma_f32_16x16x32_bf16(av, bv, acc[t], 0, 0, 0);
        }
    }
}

struct MixCtx {
    int l; unsigned char* ws; unsigned char* sb; LAS unsigned char* lds; int tid, lane, wave;
    const bf16_t* proj; bf16_t* y;
};

__device__ __forceinline__ float ret_lg(int h) { return log1pf(-exp2f(-5.0f - (float)h)); }

__device__ __forceinline__ float hg_lb(const Args& a, int l, int ch) {
    if (l == 0) return 0.f;
    const float* hb = in_ptr(a, I_HLB); return sigmoidf_(hb[256 + ch] - hb[ch]);
}

__device__ __forceinline__ void lru_m1(const Args& a, const MixCtx& c, int b, int ck_, int h) {
    const int l = c.l, tid = c.tid, lane = c.lane, wave = c.wave;
    LAS bf16_t* xcb = (LAS bf16_t*)c.lds;
    LAS float* xin = (LAS float*)(c.lds + 9216);
    LAS float* xcf = (LAS float*)(c.lds + 26368);
    LAS float* A_ = (LAS float*)(c.lds + 43008);
    LAS float* U_ = (LAS float*)(c.lds + 59648);
    const int row0 = b * SEQ + 64 * ck_;
    for (int idx = tid; idx < 67 * 8; idx += NTHREADS) { const int r = idx >> 3, q = idx & 7, t = 64 * ck_ - 3 + r; float v[8];
#pragma unroll
        for (int i = 0; i < 8; ++i) v[i] = 0.f;
        if (t >= 0) ld8bf(c.proj + (size_t)(b * SEQ + t) * NIN + C_LX + 64 * h + 8 * q, v);
#pragma unroll
        for (int i = 0; i < 8; ++i) xin[r * 64 + 8 * q + i] = v[i]; }
    __syncthreads();
    {
        const float* cw = in_ptr(a, I_LCW) + (size_t)l * 4 * 512; const float* cbias = in_ptr(a, I_LCB) + l * 512;
        const int tok = tid >> 3, q = tid & 7; float v[8];
#pragma unroll
        for (int i = 0; i < 8; ++i) { const int ch = 64 * h + 8 * q + i; float s = cbias[ch];
#pragma unroll
            for (int k = 0; k < 4; ++k) s += cw[k * 512 + ch] * xin[(tok + k) * 64 + 8 * q + i];
            xcf[tok * 65 + 8 * q + i] = s; v[i] = s; }
        *(LAS u32x4*)(xcb + tok * LD + 8 * q) = pack8(v);
    }
    __syncthreads();
    {
        const bf16_t* gwt = (const bf16_t*)(c.ws + WS_GATE) + (size_t)l * 65536;
        const bf16_t* waT = gwt + h * 4096; const bf16_t* wxT = gwt + 32768 + h * 4096;
        const int rb = wave >> 1, cb0 = (wave & 1) * 2, fr = lane & 15, fq = lane >> 4;
        f32x4 ga[2], gx[2];
#pragma unroll
        for (int t = 0; t < 2; ++t) { ga[t] = (f32x4){0.f, 0.f, 0.f, 0.f}; gx[t] = (f32x4){0.f, 0.f, 0.f, 0.f}; }
#pragma unroll
        for (int kk = 0; kk < 2; ++kk) {
            const bf16x8 av = *(const LAS bf16x8*)(xcb + (16 * rb + fr) * LD + 32 * kk + 8 * fq);
#pragma unroll
            for (int t = 0; t < 2; ++t) { const int jj = 16 * (cb0 + t) + fr;
                const bf16x8 ba_ = *(const bf16x8*)(waT + jj * 64 + 32 * kk + 8 * fq), bx_ = *(const bf16x8*)(wxT + jj * 64 + 32 * kk + 8 * fq);
                ga[t] = __builtin_amdgcn_mfma_f32_16x16x32_bf16(av, ba_, ga[t], 0, 0, 0);
                gx[t] = __builtin_amdgcn_mfma_f32_16x16x32_bf16(av, bx_, gx[t], 0, 0, 0); }
        }
        const float* ba = in_ptr(a, I_BA) + l * 512; const float* bx = in_ptr(a, I_BX) + l * 512; const float* lam = in_ptr(a, I_LAM) + l * 512;
#pragma unroll
        for (int t = 0; t < 2; ++t) { const int jj = 16 * (cb0 + t) + fr, ch = 64 * h + jj;
            const float bav = ba[ch], bxv = bx[ch], sp = log1pf(__expf(-lam[ch]));
#pragma unroll
            for (int r = 0; r < 4; ++r) { const int tok = 16 * rb + 4 * fq + r;
                const float rg = sigmoidf_(ga[t][r] + bav), ig = sigmoidf_(gx[t][r] + bxv);
                const float la = -8.0f * rg * sp; const float av_ = __expf(la);
                const float uv = sqrtf(-expm1f(2.0f * la)) * (ig * xcf[tok * 65 + jj]);
                A_[tok * 65 + jj] = av_; U_[tok * 65 + jj] = uv; }
        }
    }
    __syncthreads();
    if (tid < 64) { float hh = 0.f, P = 1.f;
        for (int t = 0; t < 64; ++t) { const float av_ = A_[t * 65 + tid], uv = U_[t * 65 + tid]; hh = av_ * hh + uv; P *= av_; U_[t * 65 + tid] = hh; A_[t * 65 + tid] = P; }
        const size_t so = (size_t)(b * NCH + ck_) * 512 + 64 * h + tid;
        ((float*)(c.ws + WS_LRUA))[so] = P; ((float*)(c.ws + WS_LRUH))[so] = hh; }
    __syncthreads();
    { const int tok = tid >> 3, q = tid & 7; float hv[8], pv[8];
#pragma unroll
        for (int i = 0; i < 8; ++i) { hv[i] = U_[tok * 65 + 8 * q + i]; pv[i] = A_[tok * 65 + 8 * q + i]; }
        *(u32x4*)(c.y + (size_t)(row0 + tok) * DM + 64 * h + 8 * q) = pack8(hv);
        *(u32x4*)((bf16_t*)(c.ws + WS_P) + (size_t)(row0 + tok) * 512 + 64 * h + 8 * q) = pack8(pv); }
    __syncthreads();
}

__device__ __forceinline__ void lru_m3(const MixCtx& c, int b, int ck_, int h) {
    const int tok = c.tid >> 3, q = c.tid & 7, row = b * SEQ + 64 * ck_ + tok, col = 64 * h + 8 * q;
    float hl[8], pv[8], g[8], o[8];
    ld8bf(c.y + (size_t)row * DM + col, hl); ld8bf((const bf16_t*)(c.ws + WS_P) + (size_t)row * 512 + col, pv); ld8bf(c.proj + (size_t)row * NIN + C_LG + col, g);
    const float* hin = (const float*)(c.ws + WS_LRUIN) + (size_t)(b * NCH + ck_) * 512 + col;
#pragma unroll
    for (int i = 0; i < 8; ++i) o[i] = (hl[i] + pv[i] * hin[i]) * gelu_tanh(g[i]);
    *(u32x4*)(c.y + (size_t)row * DM + col) = pack8(o);
}

__device__ __forceinline__ void rot8(const MixCtx& c, const bf16_t* src, int pos, int cp, float (&o1)[8], float (&o2)[8]) {
    float x1[8], x2[8]; ld8bf(src + 8 * cp, x1); ld8bf(src + 32 + 8 * cp, x2);
    const float* cosT = (const float*)(c.ws + WS_ROPE) + pos * 32 + 8 * cp; const float* sinT = cosT + SEQ * 32;
#pragma unroll
    for (int i = 0; i < 8; ++i) { const float cs = cosT[i], sn = sinT[i]; o1[i] = x1[i] * cs - x2[i] * sn; o2[i] = x2[i] * cs + x1[i] * sn; }
}
__device__ __forceinline__ void store_vT(const MixCtx& c, LAS bf16_t* vT, int row0, int vcol) {
    const int r = c.tid >> 3, q = c.tid & 7; const u32x4 w = *(const u32x4*)(c.proj + (size_t)(row0 + r) * NIN + vcol + 8 * q);
    const unsigned ww[4] = {w.x, w.y, w.z, w.w};
#pragma unroll
    for (int i = 0; i < 8; ++i) vT[(8 * q + i) * LD + r] = (bf16_t)((ww[i >> 1] >> (16 * (i & 1))) & 0xffffu);
}
__device__ __forceinline__ void store_state(f32x4 (&acc)[2], float* S, int wave, int lane) {
    const int rb = wave >> 1, cb0 = (wave & 1) * 2, fr = lane & 15, fq = lane >> 4;
#pragma unroll
    for (int t = 0; t < 2; ++t)
#pragma unroll
        for (int r = 0; r < 4; ++r) S[(16 * rb + 4 * fq + r) * 64 + 16 * (cb0 + t) + fr] = acc[t][r];
}

__device__ __forceinline__ void ret_m1(const MixCtx& c, int b, int ck_, int h) {
    LAS bf16_t* kdT = (LAS bf16_t*)c.lds; LAS bf16_t* vT = (LAS bf16_t*)(c.lds + TILE_B);
    const int row0 = b * SEQ + 64 * ck_;
    if (c.tid < 256) { const int r = c.tid >> 2, cp = c.tid & 3; float o1[8], o2[8];
        rot8(c, c.proj + (size_t)(row0 + r) * NIN + C_RK + 64 * h, 64 * ck_ + r, cp, o1, o2);
        const float sc = 0.125f * __expf((float)(63 - r) * ret_lg(h));
#pragma unroll
        for (int i = 0; i < 8; ++i) { kdT[(8 * cp + i) * LD + r] = (bf16_t)f2bf(o1[i] * sc); kdT[(32 + 8 * cp + i) * LD + r] = (bf16_t)f2bf(o2[i] * sc); } }
    store_vT(c, vT, row0, C_RV + 64 * h);
    __syncthreads();
    f32x4 acc[2] = {(f32x4){0.f, 0.f, 0.f, 0.f}, (f32x4){0.f, 0.f, 0.f, 0.f}};
    mm64(acc, vT, kdT, c.wave, c.lane);
    store_state(acc, (float*)(c.ws + WS_SRET) + (size_t)((b * NCH + ck_) * 4 + h) * 4096, c.wave, c.lane);
    __syncthreads();
}

__device__ __forceinline__ void hg_fk(const Args& a, const MixCtx& c, int row, int h, int q, LAS float* LF, int r, float (&kk)[8]) {
    float fp[8]; ld8bf(c.proj + (size_t)row * NIN + C_HF + 64 * h + 8 * q, fp);
#pragma unroll
    for (int i = 0; i < 8; ++i) { const float lb = hg_lb(a, c.l, 64 * h + 8 * q + i);
        const float e = __expf(-fabsf(fp[i]));
        const float sp = fp[i] >= 0.f ? 1.0f / (1.0f + e) : e / (1.0f + e);
        const float sn = fp[i] >= 0.f ? e / (1.0f + e) : 1.0f / (1.0f + e);
        const float lsig = (fp[i] >= 0.f ? 0.f : fp[i]) - log1pf(e);
        const float lf = (lb == 0.f) ? lsig : __logf(lb + (1.0f - lb) * sp);
        LF[r * 65 + 8 * q + i] = lf; kk[i] = (1.0f - lb) * sn; }
}
__device__ __forceinline__ void hg_cumsum(LAS float* LF, int tid) {
    if (tid < 64) { float run = 0.f; for (int m = 0; m < 64; ++m) { run += LF[m * 65 + tid]; LF[m * 65 + tid] = run; } }
}

__device__ __forceinline__ void hg_m1(const Args& a, const MixCtx& c, int b, int ck_, int h) {
    LAS bf16_t* kbT = (LAS bf16_t*)c.lds; LAS bf16_t* vT = (LAS bf16_t*)(c.lds + TILE_B); LAS float* LF = (LAS float*)(c.lds + 6 * TILE_B);
    const int row0 = b * SEQ + 64 * ck_, r = c.tid >> 3, q = c.tid & 7; float kk[8];
    hg_fk(a, c, row0 + r, h, q, LF, r, kk);
    store_vT(c, vT, row0, C_HI + 64 * h);
    __syncthreads();
    hg_cumsum(LF, c.tid);
    __syncthreads();
    if (c.tid < 64) ((float*)(c.ws + WS_HGDEC))[(size_t)((b * NCH + ck_) * 4 + h) * 64 + c.tid] = __expf(LF[63 * 65 + c.tid]);
#pragma unroll
    for (int i = 0; i < 8; ++i) { const int d = 8 * q + i; kbT[d * LD + r] = (bf16_t)f2bf(kk[i] * __expf(LF[63 * 65 + d] - LF[r * 65 + d])); }
    __syncthreads();
    f32x4 acc[2] = {(f32x4){0.f, 0.f, 0.f, 0.f}, (f32x4){0.f, 0.f, 0.f, 0.f}};
    mm64(acc, vT, kbT, c.wave, c.lane);
    store_state(acc, (float*)(c.ws + WS_SHG) + (size_t)((b * NCH + ck_) * 4 + h) * 4096, c.wave, c.lane);
    __syncthreads();
}

template <int KIND>
__device__ __forceinline__ void mix_m3(const Args& a, const MixCtx& c, int b, int ck_, int h) {
    const int tid = c.tid, lane = c.lane, wave = c.wave;
    LAS bf16_t* qr = (LAS bf16_t*)c.lds; LAS bf16_t* kr = (LAS bf16_t*)(c.lds + TILE_B); LAS bf16_t* qd = (LAS bf16_t*)(c.lds + 2 * TILE_B);
    LAS bf16_t* vT = (LAS bf16_t*)(c.lds + 3 * TILE_B); LAS bf16_t* ST = (LAS bf16_t*)(c.lds + 4 * TILE_B); LAS bf16_t* Pm = (LAS bf16_t*)(c.lds + 5 * TILE_B);
    LAS float* LF = (LAS float*)(c.lds + 6 * TILE_B);
    LAS float* OB = (LAS float*)(c.lds + 6 * TILE_B + 16640);
    const int row0 = b * SEQ + 64 * ck_;
    const float lg = ret_lg(h);
    const float* Sg = (const float*)(c.ws + (KIND == 0 ? WS_SRET : WS_SHG)) + (size_t)((b * NCH + ck_) * 4 + h) * 4096;
    { const int e = tid >> 3, q = tid & 7; const f32x4 s0 = *(const f32x4*)(Sg + e * 64 + 8 * q), s1 = *(const f32x4*)(Sg + e * 64 + 8 * q + 4);
      u32x4 w; w.x = pk2(s0[0], s0[1]); w.y = pk2(s0[2], s0[3]); w.z = pk2(s1[0], s1[1]); w.w = pk2(s1[2], s1[3]); *(LAS u32x4*)(ST + e * LD + 8 * q) = w; }
    store_vT(c, vT, row0, (KIND == 0 ? C_RV : C_HI) + 64 * h);
    if (KIND == 0) {
        const int half = tid >> 8, r = (tid & 255) >> 2, cp = tid & 3; float o1[8], o2[8];
        rot8(c, c.proj + (size_t)(row0 + r) * NIN + (half ? C_RK : C_RQ) + 64 * h, 64 * ck_ + r, cp, o1, o2);
        if (half == 0) {
            *(LAS u32x4*)(qr + r * LD + 8 * cp) = pack8(o1); *(LAS u32x4*)(qr + r * LD + 32 + 8 * cp) = pack8(o2);
            const float sc = __expf((float)(r + 1) * lg);
#pragma unroll
            for (int i = 0; i < 8; ++i) { o1[i] *= sc; o2[i] *= sc; }
            *(LAS u32x4*)(qd + r * LD + 8 * cp) = pack8(o1); *(LAS u32x4*)(qd + r * LD + 32 + 8 * cp) = pack8(o2);
        } else {
#pragma unroll
            for (int i = 0; i < 8; ++i) { o1[i] *= 0.125f; o2[i] *= 0.125f; }
            *(LAS u32x4*)(kr + r * LD + 8 * cp) = pack8(o1); *(LAS u32x4*)(kr + r * LD + 32 + 8 * cp) = pack8(o2);
        }
    } else {
        const int r = tid >> 3, q = tid & 7; float kk[8], qv[8];
        hg_fk(a, c, row0 + r, h, q, LF, r, kk);
        ld8bf(c.proj + (size_t)(row0 + r) * NIN + C_HQ + 64 * h + 8 * q, qv);
#pragma unroll
        for (int i = 0; i < 8; ++i) qv[i] = qv[i] * sigmoidf_(qv[i]);
        __syncthreads();
        hg_cumsum(LF, tid);
        __syncthreads();
        float a1[8], a2[8], a3[8];
#pragma unroll
        for (int i = 0; i < 8; ++i) { const int d = 8 * q + i; const float bn = LF[r * 65 + d], rf = LF[31 * 65 + d];
            a1[i] = qv[i] * __expf(bn - rf); a2[i] = kk[i] * __expf(rf - bn); a3[i] = qv[i] * __expf(bn); }
        *(LAS u32x4*)(qr + r * LD + 8 * q) = pack8(a1); *(LAS u32x4*)(kr + r * LD + 8 * q) = pack8(a2); *(LAS u32x4*)(qd + r * LD + 8 * q) = pack8(a3);
    }
    __syncthreads();
    const int rb = wave >> 1, cb0 = (wave & 1) * 2, fr = lane & 15, fq = lane >> 4;
    {
        f32x4 sc[2] = {(f32x4){0.f, 0.f, 0.f, 0.f}, (f32x4){0.f, 0.f, 0.f, 0.f}};
        mm64(sc, qr, kr, wave, lane);
#pragma unroll
        for (int t = 0; t < 2; ++t)
#pragma unroll
            for (int r = 0; r < 4; ++r) { const int n = 16 * rb + 4 * fq + r, m = 16 * (cb0 + t) + fr; float v = sc[t][r];
                if (KIND == 0) v *= __expf((float)(n - m) * lg);
                v = (m <= n) ? v : 0.f;
                Pm[n * LD + m] = (bf16_t)f2bf(v); }
    }
    __syncthreads();
    {
        f32x4 o[2] = {(f32x4){0.f, 0.f, 0.f, 0.f}, (f32x4){0.f, 0.f, 0.f, 0.f}};
        mm64(o, Pm, vT, wave, lane);
        mm64(o, qd, ST, wave, lane);
#pragma unroll
        for (int t = 0; t < 2; ++t)
#pragma unroll
            for (int r = 0; r < 4; ++r) OB[(16 * rb + 4 * fq + r) * 68 + 16 * (cb0 + t) + fr] = o[t][r];
    }
    __syncthreads();
    {
        const int n = tid >> 3, q = tid & 7, row = row0 + n; float v[8], g[8]; float ss = 0.f;
#pragma unroll
        for (int i = 0; i < 8; ++i) { v[i] = OB[n * 68 + 8 * q + i]; ss += v[i] * v[i]; }
        ss += bperm_f(lane ^ 1, ss); ss += bperm_f(lane ^ 2, ss); ss += bperm_f(lane ^ 4, ss);
        const float rs = rsqrtf(ss * (1.0f / 64.0f) + EPS);
        ld8bf(c.proj + (size_t)row * NIN + (KIND == 0 ? C_RG : C_HG) + 64 * h + 8 * q, g);
        const float* nw = in_ptr(a, KIND == 0 ? I_RNW : I_HNW) + c.l * 256 + 64 * h + 8 * q;
#pragma unroll
        for (int i = 0; i < 8; ++i) v[i] = v[i] * rs * nw[i] * (g[i] * sigmoidf_(g[i]));
        *(u32x4*)(c.y + (size_t)row * DM + (KIND == 0 ? 512 : 768) + 64 * h + 8 * q) = pack8(v);
    }
    __syncthreads();
}

constexpr int WLDS = 18432;
constexpr size_t OUT_SBR = 0;
constexpr size_t OUT_SBH = 16 * MiB;
#define WAVE_LDS_FENCE() asm volatile("s_waitcnt lgkmcnt(0)" ::: "memory")
__device__ __forceinline__ bf16x8 pack_frag(const float (&v)[8]) { return __builtin_bit_cast(bf16x8, pack8(v)); }
template <int N> __device__ __forceinline__ float dpp_shr0(float v) {
    return __builtin_bit_cast(float, __builtin_amdgcn_update_dpp(0, __builtin_bit_cast(int, v), 0x110 + N, 0xf, 0xf, true)); }
template <int N> __device__ __forceinline__ float dpp_shr1(float v) {
    return __builtin_bit_cast(float, __builtin_amdgcn_update_dpp(0x3f800000, __builtin_bit_cast(int, v), 0x110 + N, 0xf, 0xf, false)); }
__device__ __forceinline__ float row_sum_incl(float v) { v += dpp_shr0<1>(v); v += dpp_shr0<2>(v); v += dpp_shr0<4>(v); v += dpp_shr0<8>(v); return v; }
__device__ __forceinline__ float bcast15(float v, int lane) { return bperm_f((lane & 48) | 15, v); }

typedef short v4i16_t __attribute__((ext_vector_type(4)));
__device__ __forceinline__ unsigned long long tr4(const LAS bf16_t* T, int m0, int c0, int li) {
    const v4i16_t v = __builtin_amdgcn_ds_read_tr16_b64_v4i16((LAS v4i16_t*)(T + (m0 + (li >> 2)) * LD + c0 + 4 * (li & 3)));
    return __builtin_bit_cast(unsigned long long, v);
}
__device__ __forceinline__ bf16x8 tr_frag(const LAS bf16_t* T, int mA, int mB, int c0, int li) {
    const unsigned long long a = tr4(T, mA, c0, li), b = tr4(T, mB, c0, li);
    u32x4 w; w.x = (unsigned)a; w.y = (unsigned)(a >> 32); w.z = (unsigned)b; w.w = (unsigned)(b >> 32); return __builtin_bit_cast(bf16x8, w);
}
__device__ __forceinline__ void w_store_vT(LAS bf16_t* vN, const bf16_t* src, int lane) {
#pragma unroll
    for (int i = 0; i < 8; ++i) { const int m = (lane >> 3) + 8 * i, e0 = 8 * (lane & 7); *(LAS u32x4*)(vN + m * LD + e0) = *(const u32x4*)(src + (size_t)m * NIN + e0); }
}
__device__ __forceinline__ void w_kv(const LAS bf16_t* vN, const LAS bf16_t* kN, bf16_t* S, int lo, int fq) {
#pragma unroll
    for (int db = 0; db < 4; ++db) {
        bf16x8 kf[2];
#pragma unroll
        for (int kk = 0; kk < 2; ++kk) kf[kk] = tr_frag(kN, 32 * kk + 8 * fq, 32 * kk + 8 * fq + 4, 16 * db, lo);
#pragma unroll
        for (int eb = 0; eb < 4; ++eb) { f32x4 acc = {0.f, 0.f, 0.f, 0.f};
#pragma unroll
            for (int kk = 0; kk < 2; ++kk) { const bf16x8 vf = tr_frag(vN, 32 * kk + 8 * fq, 32 * kk + 8 * fq + 4, 16 * eb, lo); acc = __builtin_amdgcn_mfma_f32_16x16x32_bf16(kf[kk], vf, acc, 0, 0, 0); }
            *(unsigned long long*)(S + (16 * eb + lo) * 64 + 16 * db + 4 * fq) = (unsigned long long)pk2(acc[0], acc[1]) | ((unsigned long long)pk2(acc[2], acc[3]) << 32); }
    }
}

__device__ __forceinline__ void w_ret_m1(unsigned char* ws, const bf16_t* proj, LAS unsigned char* wl, int b, int ck_, int h, int lane) {
    LAS bf16_t* vT = (LAS bf16_t*)wl; LAS bf16_t* kT = (LAS bf16_t*)(wl + TILE_B);
    const int row0 = b * SEQ + 64 * ck_, lo = lane & 15, fq = lane >> 4; const float lg = ret_lg(h);
    const float* cosT = (const float*)(ws + WS_ROPE); const float* sinT = cosT + SEQ * 32;
#pragma unroll
    for (int i = 0; i < 4; ++i) { const int m = (lane >> 2) + 16 * i, cp = lane & 3; float x1[8], x2[8];
        const bf16_t* src = proj + (size_t)(row0 + m) * NIN + CR(h, 1); ld8bf(src + 8 * cp, x1); ld8bf(src + 32 + 8 * cp, x2);
        const float* cp_ = cosT + (64 * ck_ + m) * 32 + 8 * cp; const float* sp_ = sinT + (64 * ck_ + m) * 32 + 8 * cp;
        const float sc = 0.125f * __expf((float)(63 - m) * lg);
        float o1[8], o2[8];
#pragma unroll
        for (int j = 0; j < 8; ++j) { const float cs = cp_[j], sn = sp_[j]; o1[j] = (x1[j] * cs - x2[j] * sn) * sc; o2[j] = (x2[j] * cs + x1[j] * sn) * sc; }
        *(LAS u32x4*)(kT + m * LD + 8 * cp) = pack8(o1); *(LAS u32x4*)(kT + m * LD + 32 + 8 * cp) = pack8(o2); }
    w_store_vT(vT, proj + (size_t)row0 * NIN + CR(h, 2), lane);
    WAVE_LDS_FENCE();
    w_kv(vT, kT, (bf16_t*)(ws + WS_SRET) + (size_t)((b * NCH + ck_) * 4 + h) * 4096, lo, fq);
    WAVE_LDS_FENCE();
}

template <int KIND>
__device__ __forceinline__ void w_m3_core(const bf16x8 (&Qf)[4][2], const bf16x8 (&Kf)[4][2], const bf16x8 (&Sf)[4][2], const LAS bf16_t* vT, float lg,
                                          const bf16_t* gsrc, const float* nw, bf16_t* ydst, int lo, int fq) {
#pragma unroll
    for (int nb = 0; nb < 4; ++nb) {
        f32x4 O[4], O2[4];
#pragma unroll
        for (int eb = 0; eb < 4; ++eb) { O[eb] = (f32x4){0.f, 0.f, 0.f, 0.f}; O2[eb] = (f32x4){0.f, 0.f, 0.f, 0.f}; }
#pragma unroll
        for (int kk2 = 0; kk2 < 2; ++kk2) {
            if (2 * kk2 > nb) continue;
            float pv[8];
#pragma unroll
            for (int hh = 0; hh < 2; ++hh) { const int mb = 2 * kk2 + hh;
                if (mb <= nb) { f32x4 s = {0.f, 0.f, 0.f, 0.f};
                    s = __builtin_amdgcn_mfma_f32_16x16x32_bf16(Kf[mb][0], Qf[nb][0], s, 0, 0, 0); s = __builtin_amdgcn_mfma_f32_16x16x32_bf16(Kf[mb][1], Qf[nb][1], s, 0, 0, 0);
#pragma unroll
                    for (int r = 0; r < 4; ++r) { const int m = 16 * mb + 4 * fq + r, n = 16 * nb + lo; float v = s[r];
                        if (KIND == 0) v *= __expf((float)(n - m) * lg);
                        if (mb == nb) v = (m <= n) ? v : 0.f;
                        pv[4 * hh + r] = v; }
                } else {
#pragma unroll
                    for (int r = 0; r < 4; ++r) pv[4 * hh + r] = 0.f; }
            }
            const bf16x8 Pf = pack_frag(pv);
#pragma unroll
            for (int eb = 0; eb < 4; ++eb)
                O[eb] = __builtin_amdgcn_mfma_f32_16x16x32_bf16(tr_frag(vT, 32 * kk2 + 4 * fq, 32 * kk2 + 16 + 4 * fq, 16 * eb, lo), Pf, O[eb], 0, 0, 0);
        }
#pragma unroll
        for (int kk = 0; kk < 2; ++kk)
#pragma unroll
            for (int eb = 0; eb < 4; ++eb) O2[eb] = __builtin_amdgcn_mfma_f32_16x16x32_bf16(Sf[eb][kk], Qf[nb][kk], O2[eb], 0, 0, 0);
        const float osc = KIND == 0 ? __expf((float)(16 * nb + lo + 1) * lg) : 1.0f;
#pragma unroll
        for (int eb = 0; eb < 4; ++eb) O[eb] = O[eb] + O2[eb] * osc;
        float ss = 0.f;
#pragma unroll
        for (int eb = 0; eb < 4; ++eb) ss += (O[eb][0] * O[eb][0] + O[eb][1] * O[eb][1]) + (O[eb][2] * O[eb][2] + O[eb][3] * O[eb][3]);
        { const int ln = (fq << 4) | lo; ss += bperm_f(ln ^ 16, ss); ss += bperm_f(ln ^ 32, ss); }
        const float rs = rsqrtf(ss * (1.0f / 64.0f) + EPS);
        const size_t n = 16 * nb + lo;
#pragma unroll
        for (int eb = 0; eb < 4; ++eb) { const int e0 = 16 * eb + 4 * fq;
            const unsigned long long gw_ = *(const unsigned long long*)(gsrc + n * NIN + e0); const f32x4 w4 = *(const f32x4*)(nw + e0);
            const float g0 = __uint_as_float((unsigned)gw_ << 16), g1 = __uint_as_float((unsigned)gw_ & 0xffff0000u), g2 = __uint_as_float((unsigned)(gw_ >> 32) << 16), g3 = __uint_as_float((unsigned)(gw_ >> 32) & 0xffff0000u);
            const float o0 = O[eb][0] * rs * w4[0] * (g0 * sigmoidf_(g0)), o1 = O[eb][1] * rs * w4[1] * (g1 * sigmoidf_(g1));
            const float o2 = O[eb][2] * rs * w4[2] * (g2 * sigmoidf_(g2)), o3 = O[eb][3] * rs * w4[3] * (g3 * sigmoidf_(g3));
            *(unsigned long long*)(ydst + n * DM + e0) = (unsigned long long)pk2(o0, o1) | ((unsigned long long)pk2(o2, o3) << 32); }
        asm volatile("" ::: "memory");
        __builtin_amdgcn_sched_barrier(0);
    }
}

__device__ __forceinline__ void w_ret_m3(const Args& a, int l, unsigned char* ws, const bf16_t* proj, bf16_t* y, LAS unsigned char* wl, int b, int ck_, int h, int lane) {
    LAS bf16_t* vT = (LAS bf16_t*)wl;
    const int row0 = b * SEQ + 64 * ck_, lo = lane & 15, fq = lane >> 4; const float lg = ret_lg(h);
    const float* cosT = (const float*)(ws + WS_ROPE); const float* sinT = cosT + SEQ * 32;
    w_store_vT(vT, proj + (size_t)row0 * NIN + CR(h, 2), lane);
    bf16x8 Qf[4][2], Kf[4][2], Sf[4][2];
#pragma unroll
    for (int tb = 0; tb < 4; ++tb) { const int n = 16 * tb + lo; float x1[8], x2[8], o1[8], o2[8], cs[8], sn[8];
        const float* cp_ = cosT + (64 * ck_ + n) * 32 + 8 * fq; const float* sp_ = sinT + (64 * ck_ + n) * 32 + 8 * fq;
#pragma unroll
        for (int j = 0; j < 8; ++j) { cs[j] = cp_[j]; sn[j] = sp_[j]; }
        const bf16_t* qs = proj + (size_t)(row0 + n) * NIN + CR(h, 0) + 8 * fq;
        ld8bf(qs, x1); ld8bf(qs + 32, x2);
#pragma unroll
        for (int j = 0; j < 8; ++j) { o1[j] = x1[j] * cs[j] - x2[j] * sn[j]; o2[j] = x2[j] * cs[j] + x1[j] * sn[j]; }
        Qf[tb][0] = pack_frag(o1); Qf[tb][1] = pack_frag(o2);
        const bf16_t* ks = proj + (size_t)(row0 + n) * NIN + CR(h, 1) + 8 * fq;
        ld8bf(ks, x1); ld8bf(ks + 32, x2);
#pragma unroll
        for (int j = 0; j < 8; ++j) { o1[j] = (x1[j] * cs[j] - x2[j] * sn[j]) * 0.125f; o2[j] = (x2[j] * cs[j] + x1[j] * sn[j]) * 0.125f; }
        Kf[tb][0] = pack_frag(o1); Kf[tb][1] = pack_frag(o2);
    }
    const bf16_t* Sb = (const bf16_t*)((const unsigned char*)a.out + OUT_SBR) + (size_t)((b * NCH + ck_) * 4 + h) * 4096;
#pragma unroll
    for (int eb = 0; eb < 4; ++eb)
#pragma unroll
        for (int kk = 0; kk < 2; ++kk) Sf[eb][kk] = *(const bf16x8*)(Sb + (16 * eb + lo) * 64 + 32 * kk + 8 * fq);
    WAVE_LDS_FENCE();
    w_m3_core<0>(Qf, Kf, Sf, vT, lg, proj + (size_t)row0 * NIN + CR(h, 3), in_ptr(a, I_RNW) + l * 256 + 64 * h, y + (size_t)row0 * DM + 512 + 64 * h, lo, fq);
    WAVE_LDS_FENCE();
}
__device__ __forceinline__ void hg_lf_key(float fp, float lb, float& lf, float& key) {
    const float e = __expf(-fabsf(fp));
    const float rc = __builtin_amdgcn_rcpf(1.0f + e);
    const float sp = fp >= 0.f ? rc : e * rc;
    const float sn = fp >= 0.f ? e * rc : rc;
    const float lsig = (fp >= 0.f ? 0.f : fp) + __logf(rc);
    lf = (lb == 0.f) ? lsig : __logf(lb + (1.0f - lb) * sp); key = (1.0f - lb) * sn;
}
__device__ __forceinline__ void w_hg_scan(const float (&lbv)[8], const bf16_t* fsrc, int lane, float (&bb)[4][8], float (&r31)[8], float (&r63)[8]) {
    const int lo = lane & 15;
#pragma unroll
    for (int tb = 0; tb < 4; ++tb) { float fp[8]; ld8bf(fsrc + (size_t)(16 * tb + lo) * NIN, fp);
#pragma unroll
        for (int j = 0; j < 8; ++j) { float key; hg_lf_key(fp[j], lbv[j], bb[tb][j], key); } }
    float carry[8];
#pragma unroll
    for (int j = 0; j < 8; ++j) carry[j] = 0.f;
#pragma unroll
    for (int tb = 0; tb < 4; ++tb) {
#pragma unroll
        for (int j = 0; j < 8; ++j) { const float v = row_sum_incl(bb[tb][j]) + carry[j]; bb[tb][j] = v; carry[j] = bcast15(v, lane); if (tb == 1) r31[j] = carry[j]; if (tb == 3) r63[j] = carry[j]; }
        __builtin_amdgcn_sched_barrier(0);
    }
}

__device__ __forceinline__ void w_hg_m1(const Args& a, int l, unsigned char* ws, const bf16_t* proj, LAS unsigned char* wl, int b, int ck_, int h, int lane) {
    LAS bf16_t* vT = (LAS bf16_t*)wl; LAS bf16_t* kT = (LAS bf16_t*)(wl + TILE_B);
    const int row0 = b * SEQ + 64 * ck_, lo = lane & 15, fq = lane >> 4;
#pragma unroll
    for (int kk = 0; kk < 2; ++kk) { float bb[4][8], r31[8], r63[8], lbv[8];
#pragma unroll
        for (int j = 0; j < 8; ++j) lbv[j] = hg_lb(a, l, 64 * h + 32 * kk + 8 * fq + j);
        const bf16_t* fsrc = proj + (size_t)row0 * NIN + CH(h, 1) + 32 * kk + 8 * fq;
        w_hg_scan(lbv, fsrc, lane, bb, r31, r63);
#pragma unroll
        for (int tb = 0; tb < 4; ++tb) { float fp[8]; ld8bf(fsrc + (size_t)(16 * tb + lo) * NIN, fp);
            float kb[8];
#pragma unroll
            for (int j = 0; j < 8; ++j) { float lf, key; hg_lf_key(fp[j], lbv[j], lf, key); kb[j] = key * __expf(r63[j] - bb[tb][j]); }
            *(LAS u32x4*)(kT + (16 * tb + lo) * LD + 32 * kk + 8 * fq) = pack8(kb); }
        if (lo == 0) { float* dp = (float*)(ws + WS_HGDEC) + (size_t)((b * NCH + ck_) * 4 + h) * 64 + 32 * kk + 8 * fq;
#pragma unroll
            for (int j = 0; j < 8; ++j) dp[j] = __expf(r63[j]); }
        __builtin_amdgcn_sched_barrier(0);
    }
    w_store_vT(vT, proj + (size_t)row0 * NIN + CH(h, 2), lane);
    WAVE_LDS_FENCE();
    w_kv(vT, kT, (bf16_t*)(ws + WS_SHG) + (size_t)((b * NCH + ck_) * 4 + h) * 4096, lo, fq);
    WAVE_LDS_FENCE();
}

__device__ __forceinline__ void w_hg_m3(const Args& a, int l, unsigned char* ws, const bf16_t* proj, bf16_t* y, LAS unsigned char* wl, int b, int ck_, int h, int lane) {
    LAS bf16_t* vT = (LAS bf16_t*)wl;
    const int row0 = b * SEQ + 64 * ck_, lo = lane & 15, fq = lane >> 4;
    w_store_vT(vT, proj + (size_t)row0 * NIN + CH(h, 2), lane);
    bf16x8 Qf[4][2], Kf[4][2], Sf[4][2]; float er[2][8];
    const bf16_t* Sb = (const bf16_t*)((const unsigned char*)a.out + OUT_SBH) + (size_t)((b * NCH + ck_) * 4 + h) * 4096;
#pragma unroll
    for (int kk = 0; kk < 2; ++kk) { float bb[4][8], r31[8], r63[8], lbv[8];
#pragma unroll
        for (int j = 0; j < 8; ++j) lbv[j] = hg_lb(a, l, 64 * h + 32 * kk + 8 * fq + j);
        const bf16_t* fsrc = proj + (size_t)row0 * NIN + CH(h, 1) + 32 * kk + 8 * fq;
        w_hg_scan(lbv, fsrc, lane, bb, r31, r63);
#pragma unroll
        for (int tb = 0; tb < 4; ++tb) { float fp[8], qv[8], a1[8], a2[8];
            ld8bf(fsrc + (size_t)(16 * tb + lo) * NIN, fp); ld8bf(proj + (size_t)(row0 + 16 * tb + lo) * NIN + CH(h, 0) + 32 * kk + 8 * fq, qv);
#pragma unroll
            for (int j = 0; j < 8; ++j) { float lf, key; hg_lf_key(fp[j], lbv[j], lf, key);
                const float q = qv[j] * sigmoidf_(qv[j]); a1[j] = q * __expf(bb[tb][j] - r31[j]); a2[j] = key * __expf(r31[j] - bb[tb][j]); }
            Qf[tb][kk] = pack_frag(a1); Kf[tb][kk] = pack_frag(a2); }
#pragma unroll
        for (int j = 0; j < 8; ++j) er[kk][j] = __expf(r31[j]);
        __builtin_amdgcn_sched_barrier(0);
    }
#pragma unroll
    for (int kk = 0; kk < 2; ++kk)
#pragma unroll
        for (int eb = 0; eb < 4; ++eb) { float sv[8]; ld8bf(Sb + (16 * eb + lo) * 64 + 32 * kk + 8 * fq, sv);
#pragma unroll
            for (int j = 0; j < 8; ++j) sv[j] *= er[kk][j];
            Sf[eb][kk] = pack_frag(sv); }
    WAVE_LDS_FENCE();
    w_m3_core<1>(Qf, Kf, Sf, vT, 0.f, proj + (size_t)row0 * NIN + CH(h, 3), in_ptr(a, I_HNW) + l * 256 + 64 * h, y + (size_t)row0 * DM + 768 + 64 * h, lo, fq);
    WAVE_LDS_FENCE();
}

__device__ __forceinline__ void w_lru_m1(const Args& a, int l, unsigned char* ws, const bf16_t* proj, bf16_t* y, LAS unsigned char* wl, int b, int ck_, int h, int lane) {
    LAS float* xcf = (LAS float*)wl;
    const int row0 = b * SEQ + 64 * ck_, lo = lane & 15, fq = lane >> 4;
    const float* cw = in_ptr(a, I_LCW) + (size_t)l * 4 * 512; const float* cbias = in_ptr(a, I_LCB) + l * 512;
    const bf16_t* gwt = (const bf16_t*)(ws + WS_GATE) + (size_t)l * 65536;
    const bf16_t* waT = gwt + h * 4096; const bf16_t* wxT = gwt + 32768 + h * 4096;
    const float* ba = in_ptr(a, I_BA) + l * 512 + 64 * h; const float* bx = in_ptr(a, I_BX) + l * 512 + 64 * h; const float* lam = in_ptr(a, I_LAM) + l * 512 + 64 * h;
    bf16x8 nWa[2], nWx[2]; f32x4 nba, nbx, nlam;
#pragma unroll
    for (int kk = 0; kk < 2; ++kk) { nWa[kk] = *(const bf16x8*)(waT + lo * 64 + 32 * kk + 8 * fq); nWx[kk] = *(const bf16x8*)(wxT + lo * 64 + 32 * kk + 8 * fq); }
    nba = *(const f32x4*)(ba + 4 * fq); nbx = *(const f32x4*)(bx + 4 * fq); nlam = *(const f32x4*)(lam + 4 * fq);
    bf16x8 Xf[4][2];
#pragma unroll
    for (int kk = 0; kk < 2; ++kk) { const int ch0 = 64 * h + 32 * kk + 8 * fq; float w[4][8], bs[8];
#pragma unroll
        for (int j = 0; j < 8; ++j) { bs[j] = cbias[ch0 + j];
#pragma unroll
            for (int k = 0; k < 4; ++k) w[k][j] = cw[k * 512 + ch0 + j]; }
#pragma unroll
        for (int tb = 0; tb < 4; ++tb) { const int tok = 16 * tb + lo, t = 64 * ck_ + tok; float s[8];
#pragma unroll
            for (int j = 0; j < 8; ++j) s[j] = bs[j];
#pragma unroll
            for (int k = 0; k < 4; ++k) { const int tt = t - 3 + k; float x[8];
                ld8bf(proj + (size_t)(b * SEQ + (tt >= 0 ? tt : 0)) * NIN + CL(h, 0) + 32 * kk + 8 * fq, x);
#pragma unroll
                for (int j = 0; j < 8; ++j) s[j] += (tt >= 0 ? w[k][j] : 0.f) * x[j]; }
            Xf[tb][kk] = pack_frag(s);
#pragma unroll
            for (int j = 0; j < 8; ++j) xcf[tok * 65 + 32 * kk + 8 * fq + j] = s[j]; }
    }
    WAVE_LDS_FENCE();
#pragma unroll
    for (int jb = 0; jb < 4; ++jb) {
        bf16x8 WaF[2], WxF[2]; f32x4 pba, pbx, plam;
#pragma unroll
        for (int kk = 0; kk < 2; ++kk) { WaF[kk] = nWa[kk]; WxF[kk] = nWx[kk]; }
        pba = nba; pbx = nbx; plam = nlam;
        if (jb < 3) {
#pragma unroll
            for (int kk = 0; kk < 2; ++kk) { nWa[kk] = *(const bf16x8*)(waT + (16 * (jb + 1) + lo) * 64 + 32 * kk + 8 * fq); nWx[kk] = *(const bf16x8*)(wxT + (16 * (jb + 1) + lo) * 64 + 32 * kk + 8 * fq); }
            nba = *(const f32x4*)(ba + 16 * (jb + 1) + 4 * fq); nbx = *(const f32x4*)(bx + 16 * (jb + 1) + 4 * fq); nlam = *(const f32x4*)(lam + 16 * (jb + 1) + 4 * fq);
        }
        const int j0 = 16 * jb + 4 * fq;
        float bav[4], bxv[4], sp[4], hc[4], Pc[4];
#pragma unroll
        for (int r = 0; r < 4; ++r) { bav[r] = pba[r]; bxv[r] = pbx[r]; sp[r] = log1pf(__expf(-plam[r])); hc[r] = 0.f; Pc[r] = 1.f; }
#pragma unroll
        for (int tb = 0; tb < 4; ++tb) { const int tok = 16 * tb + lo;
            f32x4 ga = {0.f, 0.f, 0.f, 0.f}, gx = {0.f, 0.f, 0.f, 0.f};
#pragma unroll
            for (int kk = 0; kk < 2; ++kk) { ga = __builtin_amdgcn_mfma_f32_16x16x32_bf16(WaF[kk], Xf[tb][kk], ga, 0, 0, 0); gx = __builtin_amdgcn_mfma_f32_16x16x32_bf16(WxF[kk], Xf[tb][kk], gx, 0, 0, 0); }
            float hv[4], pv[4];
#pragma unroll
            for (int r = 0; r < 4; ++r) {
                const float rg = sigmoidf_(ga[r] + bav[r]), ig = sigmoidf_(gx[r] + bxv[r]);
                const float la = -8.0f * rg * sp[r]; float A = __expf(la);
                float U = __builtin_amdgcn_sqrtf(1.0f - A * A) * (ig * xcf[tok * 65 + j0 + r]);
                { const float As = dpp_shr1<1>(A), Us = dpp_shr0<1>(U); U = A * Us + U; A = A * As; }
                { const float As = dpp_shr1<2>(A), Us = dpp_shr0<2>(U); U = A * Us + U; A = A * As; }
                { const float As = dpp_shr1<4>(A), Us = dpp_shr0<4>(U); U = A * Us + U; A = A * As; }
                { const float As = dpp_shr1<8>(A), Us = dpp_shr0<8>(U); U = A * Us + U; A = A * As; }
                const float hh = U + A * hc[r], PP = A * Pc[r];
                hc[r] = bcast15(hh, lane); Pc[r] = bcast15(PP, lane); hv[r] = hh; pv[r] = PP; }
            { bf16_t* hp = (bf16_t*)(ws + WS_P) + (size_t)(row0 + tok) * 1024 + 128 * h + j0;
              *(unsigned long long*)hp = (unsigned long long)pk2(hv[0], hv[1]) | ((unsigned long long)pk2(hv[2], hv[3]) << 32);
              *(unsigned long long*)(hp + 64) = (unsigned long long)pk2(pv[0], pv[1]) | ((unsigned long long)pk2(pv[2], pv[3]) << 32); }
        }
        if (lo == 0) { const size_t so = (size_t)(b * NCH + ck_) * 512 + 64 * h + j0;
#pragma unroll
            for (int r = 0; r < 4; ++r) { ((float*)(ws + WS_LRUA))[so + r] = Pc[r]; ((float*)(ws + WS_LRUH))[so + r] = hc[r]; } }
    }
    WAVE_LDS_FENCE();
}
__device__ __forceinline__ void w_lru_m3(unsigned char* ws, const bf16_t* proj, bf16_t* y, int b, int ck_, int h, int lane) {
    const int q = lane & 7, col = 64 * h + 8 * q;
    const float* hinp = (const float*)(ws + WS_LRUIN) + (size_t)(b * NCH + ck_) * 512 + col;
    const f32x4 h0 = *(const f32x4*)hinp, h1 = *(const f32x4*)(hinp + 4);
    const float hin[8] = {h0[0], h0[1], h0[2], h0[3], h1[0], h1[1], h1[2], h1[3]};
#pragma unroll
    for (int i0 = 0; i0 < 8; i0 += 4) {
        u32x4 rh[4], rp[4], rg[4];
#pragma unroll
        for (int i = 0; i < 4; ++i) { const size_t row = (size_t)b * SEQ + 64 * ck_ + (lane >> 3) + 8 * (i0 + i);
            { const bf16_t* hp = (const bf16_t*)(ws + WS_P) + row * 1024 + 128 * h + 8 * q; rh[i] = *(const u32x4*)hp; rp[i] = *(const u32x4*)(hp + 64); } rg[i] = *(const u32x4*)(proj + row * NIN + CL(h, 1) + 8 * q); }
#pragma unroll
        for (int i = 0; i < 4; ++i) { const size_t row = (size_t)b * SEQ + 64 * ck_ + (lane >> 3) + 8 * (i0 + i);
            float hl[8], pv[8], g[8], o[8]; unpack8(rh[i], hl); unpack8(rp[i], pv); unpack8(rg[i], g);
#pragma unroll
            for (int j = 0; j < 8; ++j) o[j] = (hl[j] + pv[j] * hin[j]) * gelu_tanh(g[j]);
            *(u32x4*)(y + row * DM + col) = pack8(o); }
    }
}

#ifndef WAVE_KINDS
#define WAVE_KINDS 7
#endif
__device__ __forceinline__ bool kind_is_wave(int k) { return (k < 8) ? ((WAVE_KINDS & 4) != 0) : (k < 12 ? ((WAVE_KINDS & 1) != 0) : ((WAVE_KINDS & 2) != 0)); }
template <int pass>
__device__ __forceinline__ void mix_phase(const Args& a, const MixCtx& c) {
    if (WAVE_KINDS != 7) {
        for (int su = blockIdx.x; su < BATCH * NCH * 16; su += gridDim.x) {
            const int bc = su >> 4, k = ((su & 15) + (su >> 8)) & 15, b = bc / NCH, ck_ = bc % NCH;
            if (kind_is_wave(k)) continue;
            if (pass == 1) { if (k < 8) { if (!(WAVE_KINDS & 4)) lru_m1(a, c, b, ck_, k); } else if (k < 12) { if (!(WAVE_KINDS & 1)) ret_m1(c, b, ck_, k - 8); } else { if (!(WAVE_KINDS & 2)) hg_m1(a, c, b, ck_, k - 12); } }
            else { if (k < 8) { if (!(WAVE_KINDS & 4)) lru_m3(c, b, ck_, k); } else if (k < 12) { if (!(WAVE_KINDS & 1)) mix_m3<0>(a, c, b, ck_, k - 8); } else { if (!(WAVE_KINDS & 2)) mix_m3<1>(a, c, b, ck_, k - 12); } }
        }
        __syncthreads();
    }
    const int wave = __builtin_amdgcn_readfirstlane(c.tid >> 6);
    LAS unsigned char* wl = c.lds + wave * WLDS;
#define WAVE_ITEM_LOOP(COND, CALL) do { \
        for (int it = blockIdx.x * 8 + wave; it < BATCH * NCH * 16; it += gridDim.x * 8) { \
            const int bc = it >> 4, k = ((it & 15) + (it >> 8) + 4 * (it >> 11)) & 15, b = bc / NCH, ck_ = bc % NCH; if (!(COND)) continue; \
            int lane = c.tid & 63; asm volatile("" : "+v"(lane)); CALL; } } while (0)
#pragma unroll 1
    for (int st = 0; st < 3; ++st) {
        const int kind = (st + (wave >> 2)) % 3;
        if (kind == 0) { if (pass == 1) WAVE_ITEM_LOOP(k >= 8 && k < 12, w_ret_m1(c.ws, c.proj, wl, b, ck_, k - 8, lane)); else WAVE_ITEM_LOOP(k >= 8 && k < 12, w_ret_m3(a, c.l, c.ws, c.proj, c.y, wl, b, ck_, k - 8, lane)); }
        else if (kind == 1) { if (pass == 1) WAVE_ITEM_LOOP(k >= 12, w_hg_m1(a, c.l, c.ws, c.proj, wl, b, ck_, k - 12, lane)); else WAVE_ITEM_LOOP(k >= 12, w_hg_m3(a, c.l, c.ws, c.proj, c.y, wl, b, ck_, k - 12, lane)); }
        else { if (pass == 1) WAVE_ITEM_LOOP(k < 8, w_lru_m1(a, c.l, c.ws, c.proj, c.y, wl, b, ck_, k, lane)); else WAVE_ITEM_LOOP(k < 8, w_lru_m3(c.ws, c.proj, c.y, b, ck_, k, lane)); }
    }
#ifdef DUP_M3
    if (pass == 3) { WAVE_ITEM_LOOP(k >= 8 && k < 12, w_ret_m3(a, c.l, c.ws, c.proj, c.y, wl, b, ck_, k - 8, lane)); WAVE_ITEM_LOOP(k >= 12, w_hg_m3(a, c.l, c.ws, c.proj, c.y, wl, b, ck_, k - 12, lane)); }
#endif
#undef WAVE_ITEM_LOOP
}

__device__ __forceinline__ void mix_m2(const MixCtx& c) {
    const int gt = blockIdx.x * NTHREADS + c.tid, NT = gridDim.x * NTHREADS;
    if ((c.tid >> 6) == 7 && (c.tid & 63) < 8) {
        for (int idx = blockIdx.x * 8 + (c.tid & 63); idx < BATCH * 512; idx += gridDim.x * 8) { const int b = idx >> 9, ch = idx & 511;
            const float* A = (const float*)(c.ws + WS_LRUA) + (size_t)b * NCH * 512 + ch; const float* H = (const float*)(c.ws + WS_LRUH) + (size_t)b * NCH * 512 + ch;
            float* HI = (float*)(c.ws + WS_LRUIN) + (size_t)b * NCH * 512 + ch; float hh = 0.f;
            for (int c0 = 0; c0 < NCH; c0 += 32) { float av[32], hv[32];
#pragma unroll
                for (int i = 0; i < 32; ++i) { av[i] = A[(c0 + i) * 512]; hv[i] = H[(c0 + i) * 512]; }
#pragma unroll
                for (int i = 0; i < 32; ++i) { HI[(c0 + i) * 512] = hh; hh = av[i] * hh + hv[i]; } } }
    }
    if (c.tid < 256)
    for (int idx = blockIdx.x * 256 + c.tid; idx < 2 * 32768; idx += gridDim.x * 256) {
        const int kind = idx >> 15, e = idx & 32767, b = e >> 13, h = (e >> 11) & 3, pr = e & 2047, ed = 2 * pr;
        const unsigned* S = (const unsigned*)(c.ws + (kind == 0 ? WS_SRET : WS_SHG)) + (size_t)(b * NCH * 4 + h) * 2048 + pr;
        unsigned* SB = (unsigned*)(c.sb + (kind == 0 ? OUT_SBR : OUT_SBH)) + (size_t)(b * NCH * 4 + h) * 2048 + pr;
        float s0 = 0.f, s1 = 0.f;
        if (kind == 0) { const float dec = __expf(64.0f * ret_lg(h));
            for (int c0 = 0; c0 < NCH; c0 += 32) { unsigned kv[32];
#pragma unroll
                for (int i = 0; i < 32; ++i) kv[i] = S[(size_t)(c0 + i) * 8192];
#pragma unroll
                for (int i = 0; i < 32; ++i) { SB[(size_t)(c0 + i) * 8192] = pk2(s0, s1); s0 = s0 * dec + __uint_as_float(kv[i] << 16); s1 = s1 * dec + __uint_as_float(kv[i] & 0xffff0000u); } }
        } else { const float* dp = (const float*)(c.ws + WS_HGDEC) + (size_t)(b * NCH * 4 + h) * 64 + (ed & 63);
            for (int c0 = 0; c0 < NCH; c0 += 32) { unsigned kv[32]; f32x2_t dc[32];
#pragma unroll
                for (int i = 0; i < 32; ++i) { kv[i] = S[(size_t)(c0 + i) * 8192]; dc[i] = *(const f32x2_t*)(dp + (c0 + i) * 256); }
#pragma unroll
                for (int i = 0; i < 32; ++i) { SB[(size_t)(c0 + i) * 8192] = pk2(s0, s1); s0 = s0 * dc[i].x + __uint_as_float(kv[i] << 16); s1 = s1 * dc[i].y + __uint_as_float(kv[i] & 0xffff0000u); } }
        }
    }
}

__device__ __forceinline__ void final_norm(const Args& a, unsigned char* ws, int tid) {
    const int lane = tid & 63, gw = blockIdx.x * 8 + (tid >> 6), NGW = gridDim.x * 8;
    const float* ssq = (const float*)(ws + WS_SSQ); const float* fw = in_ptr(a, I_FNW); const bf16_t* xb = (const bf16_t*)(ws + WS_XB);
    f32x4 w0[2], w1[2];
#pragma unroll
    for (int j = 0; j < 2; ++j) { w0[j] = *(const f32x4*)(fw + 512 * j + 8 * lane); w1[j] = *(const f32x4*)(fw + 512 * j + 8 * lane + 4); }
    for (int m = gw; m < MROWS; m += NGW) { const float rs = rstd_of(ssq, m);
#pragma unroll
        for (int j = 0; j < 2; ++j) { float t[8]; ld8bf(xb + (size_t)m * DM + 512 * j + 8 * lane, t);
            const f32x4 o0 = (f32x4){t[0], t[1], t[2], t[3]} * rs * w0[j], o1 = (f32x4){t[4], t[5], t[6], t[7]} * rs * w1[j];
            float* op = a.out + (size_t)m * DM + 512 * j + 8 * lane; *(f32x4*)op = o0; *(f32x4*)(op + 4) = o1; } }
}

#define XB_TMO      128
#define XB_XCNT(j)  (256  + 64 * (j))
#define XB_XSUB(j)  (1280 + 64 * (j))
#define XB_XGEN(j)  (2304 + 64 * (j))
#define XB_TOP      3328
#define XB_TOPGEN   3392
#define XCD_BAR_WORDS 3456
#define XB_SPIN_CAP (1u << 18)

__device__ __forceinline__ unsigned xb_ld(unsigned* p)              { return __hip_atomic_load(p, __ATOMIC_RELAXED, __HIP_MEMORY_SCOPE_AGENT); }
__device__ __forceinline__ unsigned xb_add(unsigned* p, unsigned v) { return __hip_atomic_fetch_add(p, v, __ATOMIC_RELAXED, __HIP_MEMORY_SCOPE_AGENT); }
__device__ __forceinline__ unsigned xb_xcc_id() { return (unsigned)__builtin_amdgcn_s_getreg((3 << 11) | 20) & 0xFu; }
#define XB_SPIN(cond, bar) do { unsigned _sp = 0; while (cond) { __builtin_amdgcn_s_sleep(1); \
    if ((++_sp & 255u) == 0u) { if (xb_ld(&(bar)[XB_TMO])) break; if (_sp > XB_SPIN_CAP) { atomicAdd(&(bar)[XB_TMO], 1u); break; } } } } while (0)

struct XcdBarrier {
    unsigned* bar; unsigned x;
    volatile LAS unsigned* st;
};

__device__ __forceinline__ XcdBarrier xcd_barrier_post(unsigned* bar, volatile LAS unsigned* st) {
    XcdBarrier b; b.bar = bar; b.x = xb_xcc_id(); b.st = st;
    if (threadIdx.x == 0) (void)xb_add(&bar[XB_XCNT(b.x)], 1u);
    return b;
}
__device__ __forceinline__ void xcd_barrier_complete(unsigned* bar, unsigned x, unsigned& nloc, unsigned& nx) {
    const unsigned G = gridDim.x * gridDim.y * gridDim.z;
    unsigned sum, cnt, mine, sp = 0u;
    for (;;) {
        sum = 0u; cnt = 0u; mine = 0u;
#pragma unroll
        for (unsigned j = 0; j < 16; ++j) { const unsigned c = xb_ld(&bar[XB_XCNT(j)]); sum += c; cnt += (c > 0u) ? 1u : 0u; mine = (j == x) ? c : mine; }
        if (sum == G) break;
        __builtin_amdgcn_s_sleep(1);
        if ((++sp & 255u) == 0u) { if (xb_ld(&bar[XB_TMO])) break; if (sp > XB_SPIN_CAP) { atomicAdd(&bar[XB_TMO], 1u); break; } }
    }
    nloc = mine > 0u ? mine : 1u; nx = cnt > 0u ? cnt : 1u;
}

__device__ __forceinline__ void xcd_barrier(const XcdBarrier& b, const bool lead  ) {
    asm volatile("s_waitcnt vmcnt(0)" ::: "memory");
    __syncthreads();
    if (lead) {
        unsigned* bar = b.bar;
        __builtin_amdgcn_s_waitcnt(0);
        unsigned nloc = b.st[0], nx = b.st[1];
        if (nloc == 0u) { xcd_barrier_complete(bar, b.x, nloc, nx); b.st[0] = nloc; b.st[1] = nx; }
        const unsigned old = xb_add(&bar[XB_XSUB(b.x)], 1u);
        const unsigned gen = old / nloc;
        if (old + 1u == (gen + 1u) * nloc) {
            __builtin_amdgcn_fence(__ATOMIC_RELEASE, "agent");
            asm volatile("s_waitcnt vmcnt(0)" ::: "memory");
            const unsigned og = xb_add(&bar[XB_TOP], 1u);
            const unsigned tg = og / nx;
            if (og + 1u == (tg + 1u) * nx) xb_add(&bar[XB_TOPGEN], 1u);
            else XB_SPIN(xb_ld(&bar[XB_TOPGEN]) == tg, bar);
            __builtin_amdgcn_fence(__ATOMIC_ACQUIRE, "agent");
            xb_add(&bar[XB_XGEN(b.x)], 1u);
            asm volatile("s_waitcnt vmcnt(0)" ::: "memory");
        } else {
            XB_SPIN(xb_ld(&bar[XB_XGEN(b.x)]) == gen, bar);
            __builtin_amdgcn_fence(__ATOMIC_ACQUIRE, "agent");
            asm volatile("s_waitcnt vmcnt(0)" ::: "memory");
        }
    }
    __syncthreads();
}

#ifdef OFF_P0
#define ON_P0(...)
#else
#define ON_P0(...) __VA_ARGS__
#endif
#ifdef OFF_FN
#define ON_FN(...)
#else
#define ON_FN(...) __VA_ARGS__
#endif
#ifdef OFF_G1
#define ON_G1(...)
#else
#define ON_G1(...) __VA_ARGS__
#endif
#ifdef OFF_M2
#define ON_M2(...)
#else
#define ON_M2(...) __VA_ARGS__
#endif
#ifdef OFF_MX
#define ON_MX(...)
#else
#define ON_MX(...) __VA_ARGS__
#endif
#ifdef OFF_G2
#define ON_G2(...)
#else
#define ON_G2(...) __VA_ARGS__
#endif
#ifdef OFF_G3
#define ON_G3(...)
#else
#define ON_G3(...) __VA_ARGS__
#endif
#ifdef OFF_G4
#define ON_G4(...)
#else
#define ON_G4(...) __VA_ARGS__
#endif
constexpr int N_PHASES = 16;
__global__ void __launch_bounds__(NTHREADS, 2) fwd_kernel(Args a) {
    extern __shared__ __attribute__((aligned(16))) unsigned char lds_raw[];
    LAS unsigned char* lds = (LAS unsigned char*)lds_raw;
    { volatile LAS unsigned* st = (volatile LAS unsigned*)(lds + LDS_PHASE); if (threadIdx.x < 2) st[threadIdx.x] = 0u; }
    __syncthreads();
    const XcdBarrier bar = xcd_barrier_post((unsigned*)a.ws, (volatile LAS unsigned*)(lds + LDS_PHASE));
    const int wave_s = __builtin_amdgcn_readfirstlane(threadIdx.x >> 6);
    for (int ph = a.ph_lo; ph < a.ph_hi; ++ph) {
        unsigned char* ws = a.ws; asm volatile("" : "+s"(ws));
        bf16_t* xb = (bf16_t*)(ws + WS_XB); bf16_t* r1 = (bf16_t*)(ws + WS_R1); bf16_t* yb = (bf16_t*)(ws + WS_Y); float* ssq = (float*)(ws + WS_SSQ);
        int tid; asm volatile("v_mbcnt_lo_u32_b32 %0, -1, 0\n\tv_mbcnt_hi_u32_b32 %0, -1, %0" : "=v"(tid)); tid += wave_s * 64;
        if (ph == 0) { ON_P0(p0_prologue(a, ws, lds, tid);)
#ifdef DUP_P0
            __syncthreads(); p0_prologue(a, ws, lds, tid);
#endif
        }
        else if (ph == N_PHASES - 1) { ON_FN(final_norm(a, ws, tid);) }
        else {
            const int l = (ph - 1) / 7, k = (ph - 1) % 7;
            if (k == 0) {
                pg8::Gemm g{xb, (const bf16_t*)(ws + WS_WIN) + (size_t)l * NIN * DM, DM}; pg8::StaticOrder S; S.init(MROWS / 256, NIN / 256, gridDim.x, blockIdx.x);
                pg8::EpiProj E{r1, ssq}; ON_G1(pg8::gemm_phase<pg8::EpiProj, false>(lds, g, S, E, tid);)
#ifdef DUP_G1
                __syncthreads(); pg8::gemm_phase<pg8::EpiProj, false>(lds, g, S, E, tid);
#endif
            } else if (k >= 1 && k <= 3) {
                MixCtx c; c.l = l; c.ws = ws; c.sb = (unsigned char*)a.out; c.lds = lds; c.tid = tid; c.lane = tid & 63; c.wave = tid >> 6; c.proj = r1; c.y = yb;
                if (k == 2) { ON_M2(mix_m2(c);)
#ifdef DUP_M2
                    __syncthreads(); mix_m2(c);
#endif
                } else if (k == 1) { ON_MX(mix_phase<1>(a, c);) } else { ON_MX(mix_phase<3>(a, c);) }
#ifdef DUP_M1
                if (k == 1) { __syncthreads(); mix_phase<1>(a, c); }
#endif
            } else if (k == 4) {
                pg8::Gemm g{yb, (const bf16_t*)(ws + WS_WOUT) + (size_t)l * DM * DM, DM}; pg8::StaticOrder S; S.init(MROWS / 256, DM / 256, gridDim.x, blockIdx.x);
                pg8::EpiResid E{l == 0 ? in_ptr(a, I_X) : nullptr, xb, ssq}; ON_G2(pg8::gemm_phase<pg8::EpiResid, false>(lds, g, S, E, tid);)
#ifdef DUP_G2
                if (l == 0) { __syncthreads(); pg8::gemm_phase<pg8::EpiResid, false>(lds, g, S, E, tid); }
#endif
            } else if (k == 5) {
                pg8::Gemm g{xb, (const bf16_t*)(ws + WS_WUP) + (size_t)l * NUP * DM, DM}; pg8::StaticOrder S; S.init(BATCH * UPU, NUP / 256, gridDim.x, blockIdx.x);
                pg8::EpiFfn E{r1, ssq, in_ptr(a, I_FCW) + (size_t)l * 3 * NUP, in_ptr(a, I_FCB) + (size_t)l * NUP}; ON_G3(pg8::gemm_phase<pg8::EpiFfn, true>(lds, g, S, E, tid);)
#ifdef DUP_G3
                __syncthreads(); pg8::gemm_phase<pg8::EpiFfn, true>(lds, g, S, E, tid);
#endif
            } else {
                pg8::Gemm g{r1, (const bf16_t*)(ws + WS_WDN) + (size_t)l * DM * DFF, DFF}; pg8::StaticOrder S; S.init(MROWS / 256, DM / 256, gridDim.x, blockIdx.x);
                pg8::EpiResid E{nullptr, xb, ssq}; ON_G4(pg8::gemm_phase<pg8::EpiResid, false>(lds, g, S, E, tid);)
            }
        }
        if (ph + 1 < a.ph_hi) { if (a.ph_hi > N_PHASES) { __syncthreads(); cg::this_grid().sync(); } else xcd_barrier(bar, tid == 0); }
    }
}

extern "C" void kernel_launch(void* const* d_in, const int* in_sizes, int n_in, void* d_out, int out_size, void* d_ws, size_t ws_size, hipStream_t stream) {
    static int grid = 0;
    if (grid == 0) {
        if (n_in != 20 || in_sizes[0] != MROWS * DM || out_size != MROWS * DM || ws_size < WS_END) {
            fprintf(stderr, "kernel_launch: unexpected problem: n_in %d in0 %d out %d ws %zu (need %zu)\n", n_in, n_in > 0 ? in_sizes[0] : -1, out_size, ws_size, (size_t)WS_END); grid = -1; return; }
        int dev = 0, cus = 0, per_cu = 0;
        (void)hipGetDevice(&dev); (void)hipDeviceGetAttribute(&cus, hipDeviceAttributeMultiprocessorCount, dev);
        if (hipFuncSetAttribute((const void*)fwd_kernel, hipFuncAttributeMaxDynamicSharedMemorySize, LDS_BYTES) != hipSuccess) { fprintf(stderr, "kernel_launch: hipFuncSetAttribute failed\n"); grid = -1; return; }
        if (hipOccupancyMaxActiveBlocksPerMultiprocessor(&per_cu, (const void*)fwd_kernel, NTHREADS, LDS_BYTES) != hipSuccess || per_cu < 1) { fprintf(stderr, "kernel_launch: occupancy query says %d\n", per_cu); per_cu = 1; }
        (void)hipGetLastError();
        grid = cus > 0 ? cus : 256;
    }
    if (grid < 0) return;
    Args a{};
    for (int i = 0; i < 20; ++i) a.in[i] = (const float*)d_in[i];
    a.out = (float*)d_out; a.ws = (unsigned char*)d_ws;
#if MK_ONE_LAUNCH
    if (hipMemsetAsync(d_ws, 0, XCD_BAR_WORDS * 4, stream) != hipSuccess) { fprintf(stderr, "kernel_launch: hipMemsetAsync failed\n"); return; }
    a.ph_lo = 0; a.ph_hi = N_PHASES;
    void* args[] = {&a};
    hipError_t e = hipLaunchCooperativeKernel((const void*)fwd_kernel, dim3(grid), dim3(NTHREADS), args, LDS_BYTES, stream);
    if (e != hipSuccess) fprintf(stderr, "kernel_launch: cooperative launch failed: %s (grid %d)\n", hipGetErrorString(e), grid);
#else
    for (int ph = 0; ph < N_PHASES; ++ph) { a.ph_lo = ph; a.ph_hi = ph + 1; hipLaunchKernelGGL(fwd_kernel, dim3(grid), dim3(NTHREADS), LDS_BYTES, stream, a); }
#endif
}
```

```cpp
#include <hip/hip_runtime.h>
#include <hip/hip_cooperative_groups.h>
#include <cstdio>
#include <cstdint>
namespace cg = cooperative_groups;

#ifndef MK_ONE_LAUNCH
#define MK_ONE_LAUNCH 1
#endif

#define LAS __attribute__((address_space(3)))
typedef unsigned short bf16_t;
typedef short bf16x8 __attribute__((ext_vector_type(8)));
typedef float f32x4 __attribute__((ext_vector_type(4)));
typedef unsigned u32x4 __attribute__((ext_vector_type(4)));

constexpr int BATCH = 4, SEQ = 8192, DM = 1024, MROWS = BATCH * SEQ;
constexpr int NIN = 3072, DFF = 2816, NUP = 2 * DFF;
constexpr int NCH = SEQ / 64;
constexpr float EPS = 1e-6f;
constexpr int C_LX = 0, C_LG = 512, C_RQ = 1024, C_RK = 1280, C_RV = 1536, C_RG = 1792, C_HQ = 2048, C_HF = 2304, C_HI = 2560, C_HG = 2816;
__host__ __device__ constexpr int CL(int h, int t) { return 128 * h + 64 * t; }
__host__ __device__ constexpr int CR(int h, int t) { return 1024 + 256 * h + 64 * t; }
__host__ __device__ constexpr int CH(int h, int t) { return 2048 + 256 * h + 64 * t; }
__host__ __device__ constexpr int proj_col_of(int n) {
    if (n < 1024) return 128 * ((n & 511) >> 6) + 64 * (n >> 9) + (n & 63);
    const int base = n < 2048 ? 1024 : 2048, r = n - base; return base + 256 * ((r & 255) >> 6) + 64 * (r >> 8) + (r & 63);
}
constexpr int UPU = 33;

constexpr size_t MiB = 1u << 20;
constexpr size_t WS_WIN = 1 * MiB;
constexpr size_t WS_WOUT = 13 * MiB;
constexpr size_t WS_WUP = 17 * MiB;
constexpr size_t WS_WDN = 39 * MiB;
constexpr size_t WS_GATE = 50 * MiB;
constexpr size_t WS_ROPE = 51 * MiB;
constexpr size_t WS_SSQ = 53 * MiB;
constexpr size_t WS_LRUA = 55 * MiB;
constexpr size_t WS_LRUH = 56 * MiB;
constexpr size_t WS_LRUIN = 57 * MiB;
constexpr size_t WS_HGDEC = 58 * MiB;
constexpr size_t WS_XB = 64 * MiB;
constexpr size_t WS_R1 = 128 * MiB;
constexpr size_t WS_Y = 320 * MiB;
constexpr size_t WS_P = 384 * MiB;
constexpr size_t WS_SRET = 416 * MiB;
constexpr size_t WS_SHG = 448 * MiB;
constexpr size_t WS_END = 480 * MiB;

constexpr int LDS_PHASE = 147456;
constexpr int LDS_BYTES = LDS_PHASE + 256;
constexpr int NTHREADS = 512;

typedef float f32x2_t __attribute__((ext_vector_type(2)));
typedef __bf16 bf16x2_t __attribute__((ext_vector_type(2)));
__device__ __forceinline__ unsigned pk2(float lo, float hi) { const f32x2_t v = {lo, hi}; const bf16x2_t b = __builtin_convertvector(v, bf16x2_t); return __builtin_bit_cast(unsigned, b); }
__device__ __forceinline__ unsigned f2bf(float f) { return pk2(f, f) & 0xffffu; }
__device__ __forceinline__ u32x4 pack8(const float (&v)[8]) { u32x4 w; w.x = pk2(v[0], v[1]); w.y = pk2(v[2], v[3]); w.z = pk2(v[4], v[5]); w.w = pk2(v[6], v[7]); return w; }
__device__ __forceinline__ void unpack8(u32x4 w, float (&o)[8]) {
    o[0] = __uint_as_float(w.x << 16); o[1] = __uint_as_float(w.x & 0xffff0000u); o[2] = __uint_as_float(w.y << 16); o[3] = __uint_as_float(w.y & 0xffff0000u);
    o[4] = __uint_as_float(w.z << 16); o[5] = __uint_as_float(w.z & 0xffff0000u); o[6] = __uint_as_float(w.w << 16); o[7] = __uint_as_float(w.w & 0xffff0000u);
}
__device__ __forceinline__ void ld8bf(const bf16_t* p, float (&o)[8]) { unpack8(*(const u32x4*)p, o); }
__device__ __forceinline__ float sigmoidf_(float x) { return __builtin_amdgcn_rcpf(1.0f + __expf(-x)); }
template <int N> __device__ __forceinline__ float dpp_ror(float v) { return __builtin_bit_cast(float, __builtin_amdgcn_update_dpp(0, __builtin_bit_cast(int, v), 0x120 + N, 0xf, 0xf, false)); }
__device__ __forceinline__ float gelu_tanh(float x) { const float z = 0.7978845608028654f * (x + 0.044715f * x * x * x); const float t = 1.0f - 2.0f * __builtin_amdgcn_rcpf(__expf(2.0f * z) + 1.0f); return 0.5f * x * (1.0f + t); }
__device__ __forceinline__ float bperm_f(int src_lane, float v) { return __builtin_bit_cast(float, __builtin_amdgcn_ds_bpermute(src_lane << 2, __builtin_bit_cast(int, v))); }
__device__ __forceinline__ float rstd_q(const float* ssq, int row, int fr, int fq) {
    const f32x4 p = *(const f32x4*)(ssq + (size_t)row * 16 + 4 * fq);
    float s = (p[0] + p[1]) + (p[2] + p[3]);
    const int ln = (fq << 4) | fr; s += bperm_f(ln ^ 16, s); s += bperm_f(ln ^ 32, s);
    return rsqrtf(s * (1.0f / DM) + EPS);
}
__device__ __forceinline__ float rstd_of(const float* ssq, int row) {
    const f32x4* p = (const f32x4*)(ssq + (size_t)row * 16);
    const f32x4 a = p[0], b = p[1], c = p[2], d = p[3];
    const float s = ((a[0] + a[1]) + (a[2] + a[3])) + ((b[0] + b[1]) + (b[2] + b[3])) + ((c[0] + c[1]) + (c[2] + c[3])) + ((d[0] + d[1]) + (d[2] + d[3]));
    return rsqrtf(s * (1.0f / DM) + EPS);
}
#define LDS_WAIT() asm volatile("s_waitcnt lgkmcnt(0)" ::: "memory")

namespace pg8 {
#define PG8_LAS __attribute__((address_space(3)))
constexpr int BM = 256, BK = 64, HALF = 128, HTB = HALF * BK * 2, NXCD = 8, WGM = 8;
__host__ __device__ __forceinline__ int lds_byte(int r, int c) { const int st = (r >> 4) * 2 + (c >> 5), rr = r & 15, cc = c & 31, ob = rr * 64 + cc * 2; return st * 1024 + (ob ^ (((ob >> 9) & 1) << 5)); }
__host__ __device__ __forceinline__ void stage_rc(int b, int& R, int& C) { const int st = b / 1024, sb = b % 1024, swz = sb ^ (((sb >> 9) & 1) << 5); R = (st >> 1) * 16 + swz / 64; C = (st & 1) * 32 + (swz % 64) / 2; }
__host__ __device__ __forceinline__ int perm32(int rho) { const int n = rho >> 4, i = rho & 15; return 8 * (i >> 2) + 4 * n + (i & 3); }

struct Unit { int pm, pn; };
struct Gemm { const bf16_t* A; const bf16_t* Bt; int K; };

struct StaticOrder {
    int nM, nN, nwg, G, c;
    __host__ __device__ void init(int nM_, int nN_, int G_, int c_) { nM = nM_; nN = nN_; nwg = nM * nN; G = G_; c = c_; }
    __host__ __device__ bool next(int i, Unit& u) const {
        const long L = (long)i * G + c; if (L >= nwg) return false;
        int wgid = (int)L; { const int q = nwg / NXCD, r = nwg % NXCD, xcd = wgid % NXCD, off = wgid / NXCD; wgid = (xcd < r ? xcd * (q + 1) : r * (q + 1) + (xcd - r) * q) + off; }
        const int nig = WGM * nN, gid = wgid / nig, fm = gid * WGM, gsz = (nM - fm) < WGM ? (nM - fm) : WGM;
        u.pm = fm + ((wgid % nig) % gsz); u.pn = (wgid % nig) / gsz; return true;
    }
};

template <bool HALO> __device__ __forceinline__ size_t a_unit_off(int pm, int K) {
    if (HALO) return ((size_t)(pm / UPU) * SEQ + (size_t)(pm % UPU) * 252) * (size_t)K * 2;
    return (size_t)pm * 256 * (size_t)K * 2;
}

template <class Epi, bool HALO>
__device__ __forceinline__ void gemm_phase(PG8_LAS unsigned char* lds, const Gemm g, const StaticOrder& S, const Epi& E, const int tid) {
    const int wid = __builtin_amdgcn_readfirstlane(tid >> 6), lane = tid & 63, wr = wid >> 2, wc = wid & 3, fr = lane & 15, fq = lane >> 4;
    const int K = g.K, nt = K / BK;
    int voffA[2], voffB[2];
#pragma unroll
    for (int i = 0; i < 2; ++i) { int R, C; stage_rc(tid * 16 + i * 8192, R, C); const int Rb = (R & ~31) + perm32(R & 31);
        const int Ra = HALO ? (126 * (R >> 6) - 2 + (R & 63)) : R;
        voffA[i] = (Ra * K + C) * 2; voffB[i] = (Rb * K + C) * 2; }
    const size_t kstep = (size_t)(BK * 2);
    const size_t hstepB = (size_t)HALF * K * 2;
    const size_t hstepA = HALO ? (size_t)64 * K * 2 : (size_t)HALF * K * 2;
    const size_t tstepB = 2 * hstepB;
    const unsigned ldsw = (unsigned)wid * 1024u;
    const int aoff = lds_byte(wr * 64 + fr, fq * 8), boff = lds_byte(wc * 32 + fr, fq * 8);
#define PG8_SA(b, h) (((b) * 2 + (h)) * HTB)
#define PG8_SB(b, h) ((4 + (b) * 2 + (h)) * HTB)
#define PG8_STAGE(bufoff, gbase, voff) do { _Pragma("unroll") for (int _i = 0; _i < 2; ++_i) \
        __builtin_amdgcn_global_load_lds((const unsigned*)((const char*)(gbase) + (voff)[_i]), (PG8_LAS unsigned*)(lds + (bufoff) + ldsw + _i * 8192), 16, 0, 0); } while (0)
#define PG8_LDA(dst, b, h) do { _Pragma("unroll") for (int m = 0; m < 4; ++m) _Pragma("unroll") for (int k = 0; k < 2; ++k) dst[m][k] = *(const PG8_LAS bf16x8*)(lds + PG8_SA(b, h) + aoff + m * 2048 + k * 1024); } while (0)
#define PG8_LDB(dst, b, h) do { _Pragma("unroll") for (int n = 0; n < 2; ++n) _Pragma("unroll") for (int k = 0; k < 2; ++k) dst[n][k] = *(const PG8_LAS bf16x8*)(lds + PG8_SB(b, h) + boff + n * 2048 + k * 1024); } while (0)
#define PG8_MMA(ai, bj, At, Bt) do { __builtin_amdgcn_s_setprio(1); _Pragma("unroll") for (int m = 0; m < 4; ++m) _Pragma("unroll") for (int n = 0; n < 2; ++n) _Pragma("unroll") for (int k = 0; k < 2; ++k) \
        acc[ai][bj][m][n] = __builtin_amdgcn_mfma_f32_16x16x32_bf16(Bt[n][k], At[m][k], acc[ai][bj][m][n], 0, 0, 0); __builtin_amdgcn_s_setprio(0); } while (0)
#define PG8_WAIT_V(n) asm volatile("s_waitcnt vmcnt(" #n ")" ::: "memory")
#define PG8_WAIT_L(n) asm volatile("s_waitcnt lgkmcnt(" #n ")" ::: "memory")
#define PG8_BAR __builtin_amdgcn_s_barrier()
#define PG8_SCHED __builtin_amdgcn_sched_barrier(0)
    Unit cur, nxt; int ui = 0;
    if (!S.next(0, cur)) return;
    f32x4 acc[2][2][4][2];
#pragma unroll
    for (int a = 0; a < 2; ++a)
#pragma unroll
        for (int b = 0; b < 2; ++b)
#pragma unroll
            for (int m = 0; m < 4; ++m)
#pragma unroll
                for (int n = 0; n < 2; ++n) acc[a][b][m][n] = (f32x4){0.f, 0.f, 0.f, 0.f};
    bf16x8 At[4][2], B0[2][2], B1[2][2];
    const char* cA = (const char*)g.A + a_unit_off<HALO>(cur.pm, K); const char* cB = (const char*)g.Bt + (size_t)cur.pn * tstepB;
    PG8_STAGE(PG8_SB(0, 0), cB, voffB); PG8_STAGE(PG8_SB(0, 1), cB + hstepB, voffB); PG8_STAGE(PG8_SA(0, 0), cA, voffA); PG8_STAGE(PG8_SA(0, 1), cA + hstepA, voffA);
    if (wr == 1) PG8_BAR;
    PG8_WAIT_V(2); PG8_BAR;
    PG8_STAGE(PG8_SB(1, 0), cB + kstep, voffB); PG8_STAGE(PG8_SA(1, 0), cA + kstep, voffA); PG8_STAGE(PG8_SB(1, 1), cB + hstepB + kstep, voffB);
    PG8_WAIT_V(6); PG8_BAR;
    for (;;) {
        const bool has_next = S.next(ui + 1, nxt);
        const char* nA = has_next ? (const char*)g.A + a_unit_off<HALO>(nxt.pm, K) : cA; const char* nB = has_next ? (const char*)g.Bt + (size_t)nxt.pn * tstepB : cB;
        for (int t = 0; t < nt; t += 2) {
            const bool last = (t == nt - 2);
            const char* a1 = cA + (size_t)(t + 1) * kstep;
            const char* a2 = last ? nA : cA + (size_t)(t + 2) * kstep; const char* b2 = last ? nB : cB + (size_t)(t + 2) * kstep;
            const char* a3 = a2 + kstep; const char* b3 = b2 + kstep;
            PG8_LDB(B0, 0, 0); PG8_LDB(B1, 0, 1); PG8_SCHED; PG8_LDA(At, 0, 0); PG8_STAGE(PG8_SA(1, 1), a1 + hstepA, voffA);
            PG8_WAIT_V(8); PG8_WAIT_L(0); PG8_BAR; PG8_MMA(0, 0, At, B0); PG8_MMA(0, 1, At, B1); PG8_BAR; PG8_SCHED;
            PG8_LDA(At, 0, 1); PG8_STAGE(PG8_SB(0, 0), b2, voffB); PG8_STAGE(PG8_SB(0, 1), b2 + hstepB, voffB); PG8_STAGE(PG8_SA(0, 0), a2, voffA);
            PG8_WAIT_V(8); PG8_WAIT_L(0); PG8_BAR; PG8_MMA(1, 0, At, B0); PG8_MMA(1, 1, At, B1); PG8_BAR; PG8_SCHED;
            PG8_LDB(B0, 1, 0); PG8_LDB(B1, 1, 1); PG8_SCHED; PG8_LDA(At, 1, 0); PG8_STAGE(PG8_SA(0, 1), a2 + hstepA, voffA);
            PG8_WAIT_V(8); PG8_WAIT_L(0); PG8_BAR; PG8_MMA(0, 0, At, B0); PG8_MMA(0, 1, At, B1); PG8_BAR; PG8_SCHED;
            PG8_LDA(At, 1, 1); PG8_STAGE(PG8_SB(1, 0), b3, voffB); PG8_STAGE(PG8_SB(1, 1), b3 + hstepB, voffB); PG8_STAGE(PG8_SA(1, 0), a3, voffA);
            PG8_WAIT_V(8); PG8_WAIT_L(0); PG8_BAR; PG8_MMA(1, 0, At, B0); PG8_MMA(1, 1, At, B1); PG8_BAR; PG8_SCHED;
        }
        if (wr == 0) PG8_BAR;
        E(acc, cur, wr, wc, fr, fq);
        if (!has_next) break;
#pragma unroll
        for (int a = 0; a < 2; ++a)
#pragma unroll
            for (int b = 0; b < 2; ++b)
#pragma unroll
                for (int m = 0; m < 4; ++m)
#pragma unroll
                    for (int n = 0; n < 2; ++n) acc[a][b][m][n] = (f32x4){0.f, 0.f, 0.f, 0.f};
        cur = nxt; cA = nA; cB = nB; ++ui;
        if (wr == 1) PG8_BAR;
    }
    PG8_WAIT_V(0);
    PG8_BAR;
#undef PG8_SA
#undef PG8_SB
#undef PG8_STAGE
#undef PG8_LDA
#undef PG8_LDB
#undef PG8_MMA
#undef PG8_WAIT_V
#undef PG8_WAIT_L
#undef PG8_BAR
#undef PG8_SCHED
}

typedef f32x4 Acc[2][2][4][2];

struct EpiProj {
    bf16_t* O; const float* ssq;
    __device__ __forceinline__ void operator()(Acc& acc, const Unit& u, int wr, int wc, int fr, int fq) const {
        const int row0 = u.pm * 256 + wr * 64 + fr, col0 = u.pn * 256 + wc * 32 + 8 * fq, ln = (fq << 4) | fr;
        f32x4 pq[8];
#pragma unroll
        for (int q = 0; q < 8; ++q) pq[q] = *(const f32x4*)(ssq + (size_t)(row0 + (q >> 2) * 128 + (q & 3) * 16) * 16 + 4 * fq);
#pragma unroll
        for (int ai = 0; ai < 2; ++ai)
#pragma unroll
            for (int m = 0; m < 4; ++m) {
                const int row = row0 + ai * 128 + m * 16; const f32x4 p = pq[ai * 4 + m];
                float sq = (p[0] + p[1]) + (p[2] + p[3]); sq += bperm_f(ln ^ 16, sq); sq += bperm_f(ln ^ 32, sq);
                const float rs = rsqrtf(sq * (1.0f / DM) + EPS);
                bf16_t* rowp = O + (size_t)row * NIN + col0;
#pragma unroll
                for (int bj = 0; bj < 2; ++bj) { const f32x4 v0 = acc[ai][bj][m][0] * rs, v1 = acc[ai][bj][m][1] * rs;
                    u32x4 w; w.x = pk2(v0[0], v0[1]); w.y = pk2(v0[2], v0[3]); w.z = pk2(v1[0], v1[1]); w.w = pk2(v1[2], v1[3]);
                    *(u32x4*)(rowp + bj * 128) = w; }
            }
    }
};

struct EpiResid {
    const float* basef; bf16_t* xb; float* ssq;
    __device__ __forceinline__ void operator()(Acc& acc, const Unit& u, int wr, int wc, int fr, int fq) const {
        const int row0 = u.pm * 256 + wr * 64 + fr, col0 = u.pn * 256 + wc * 32 + 8 * fq, ln = (fq << 4) | fr;
#pragma unroll
        for (int ai = 0; ai < 2; ++ai)
#pragma unroll
          for (int mh = 0; mh < 2; ++mh) {
            f32x4 b0[2][2], b1[2][2];
            if (basef) {
#pragma unroll
                for (int mm = 0; mm < 2; ++mm)
#pragma unroll
                    for (int bj = 0; bj < 2; ++bj) { const size_t off = (size_t)(row0 + ai * 128 + (2 * mh + mm) * 16) * DM + col0 + bj * 128; b0[mm][bj] = *(const f32x4*)(basef + off); b1[mm][bj] = *(const f32x4*)(basef + off + 4); }
            } else {
                u32x4 raw[2][2];
#pragma unroll
                for (int mm = 0; mm < 2; ++mm)
#pragma unroll
                    for (int bj = 0; bj < 2; ++bj) raw[mm][bj] = *(const u32x4*)(xb + (size_t)(row0 + ai * 128 + (2 * mh + mm) * 16) * DM + col0 + bj * 128);
#pragma unroll
                for (int mm = 0; mm < 2; ++mm)
#pragma unroll
                    for (int bj = 0; bj < 2; ++bj) { float t[8]; unpack8(raw[mm][bj], t); b0[mm][bj] = (f32x4){t[0], t[1], t[2], t[3]}; b1[mm][bj] = (f32x4){t[4], t[5], t[6], t[7]}; }
            }
#pragma unroll
            for (int mm = 0; mm < 2; ++mm) { const int m = 2 * mh + mm;
                const int row = row0 + ai * 128 + m * 16; float ss = 0.f;
#pragma unroll
                for (int bj = 0; bj < 2; ++bj) { const size_t off = (size_t)row * DM + col0 + bj * 128;
                    const f32x4 v0 = acc[ai][bj][m][0] + b0[mm][bj], v1 = acc[ai][bj][m][1] + b1[mm][bj];
                    u32x4 w; w.x = pk2(v0[0], v0[1]); w.y = pk2(v0[2], v0[3]); w.z = pk2(v1[0], v1[1]); w.w = pk2(v1[2], v1[3]);
                    *(u32x4*)(xb + off) = w;
                    ss += (v0[0] * v0[0] + v0[1] * v0[1]) + (v0[2] * v0[2] + v0[3] * v0[3]) + (v1[0] * v1[0] + v1[1] * v1[1]) + (v1[2] * v1[2] + v1[3] * v1[3]); }
                ss += bperm_f(ln ^ 16, ss); ss += bperm_f(ln ^ 32, ss);
                if (fq == 0) ssq[(size_t)row * 16 + u.pn * 4 + wc] = ss;
            }
          }
    }
};

struct EpiFfn {
    bf16_t* act; const float* ssq; const float* cw; const float* cb;
    __device__ __forceinline__ void operator()(Acc& acc, const Unit& u, int wr, int wc, int fr, int fq) const {
        const int b = u.pm / UPU, j = u.pm % UPU;
        const int tbase = 252 * j + 126 * wr - 2 + fr;
        const int ch0 = 128 * u.pn + 32 * wc + 8 * fq;
        float chain = 0.f;
        { const int ln = (fq << 4) | fr; f32x4 pq[8];
#pragma unroll
          for (int q = 0; q < 8; ++q) { const int t = tbase + 16 * q; const bool ok = (t >= 0) && (t < SEQ); pq[q] = *(const f32x4*)(ssq + (size_t)(b * SEQ + (ok ? t : 0)) * 16 + 4 * fq); }
#pragma unroll
          for (int q = 0; q < 8; ++q) {
            const int t = tbase + 16 * q; const bool ok = (t >= 0) && (t < SEQ);
            float sq = (pq[q][0] + pq[q][1]) + (pq[q][2] + pq[q][3]); sq += bperm_f(ln ^ 16, sq); sq += bperm_f(ln ^ 32, sq);
            const float rs = rsqrtf(sq * (1.0f / DM) + EPS);
#pragma unroll
            for (int bj = 0; bj < 2; ++bj)
#pragma unroll
                for (int n = 0; n < 2; ++n)
#pragma unroll
                    for (int i = 0; i < 4; ++i) { const float v = acc[q >> 2][bj][q & 3][n][i]; acc[q >> 2][bj][q & 3][n][i] = ok ? v * rs : 0.f; }
          }
          __builtin_amdgcn_sched_barrier(0);
        }
#pragma unroll
        for (int n = 0; n < 2; ++n) {
#pragma unroll
            for (int i = 0; i < 4; ++i) {
                const int cg_ = ch0 + 4 * n + i, cv_ = DFF + cg_;
                const float g0 = cw[cg_], g1 = cw[NUP + cg_], g2 = cw[2 * NUP + cg_], gb = cb[cg_];
                const float v0 = cw[cv_], v1 = cw[NUP + cv_], v2 = cw[2 * NUP + cv_], vb = cb[cv_];
                float pg1 = 0.f, pg2 = 0.f, pv1 = 0.f, pv2 = 0.f;
#pragma unroll
                for (int q = 0; q < 8; ++q) {
                    float cgv = acc[q >> 2][0][q & 3][n][i], cvv = acc[q >> 2][1][q & 3][n][i];
                    asm volatile("" : "+v"(cgv), "+v"(cvv) : "v"(chain));
                    const float tg1 = dpp_ror<1>(cgv), tg2 = dpp_ror<2>(cgv), tv1 = dpp_ror<1>(cvv), tv2 = dpp_ror<2>(cvv);
                    const float sg1 = fr >= 1 ? tg1 : pg1, sg2 = fr >= 2 ? tg2 : pg2, sv1 = fr >= 1 ? tv1 : pv1, sv2 = fr >= 2 ? tv2 : pv2;
                    const float gg = gb + g0 * sg2 + g1 * sg1 + g2 * cgv;
                    const float vv = vb + v0 * sv2 + v1 * sv1 + v2 * cvv;
                    chain = gg * sigmoidf_(gg) * vv; acc[q >> 2][0][q & 3][n][i] = chain;
                    pg1 = tg1; pg2 = tg2; pv1 = tv1; pv2 = tv2;
                }
                __builtin_amdgcn_sched_barrier(0);
            }
        }
#pragma unroll
        for (int q = 0; q < 8; ++q) {
            const int t = tbase + 16 * q;
            if ((16 * q + fr >= 2) && (t < SEQ)) {
                const f32x4 a0 = acc[q >> 2][0][q & 3][0], a1 = acc[q >> 2][0][q & 3][1];
                u32x4 w; w.x = pk2(a0[0], a0[1]); w.y = pk2(a0[2], a0[3]); w.z = pk2(a1[0], a1[1]); w.w = pk2(a1[2], a1[3]);
                *(u32x4*)(act + (size_t)(b * SEQ + t) * DFF + ch0) = w;
            }
        }
    }
};
}

struct Args { const float* in[20]; float* out; unsigned char* ws; int ph_lo, ph_hi; };
enum { I_X = 0, I_N1, I_WIN, I_LCW, I_LCB, I_WA, I_BA, I_WX, I_BX, I_LAM, I_RNW, I_HLB, I_HNW, I_WOUT, I_N2, I_WUP, I_FCW, I_FCB, I_WDN, I_FNW };
__device__ __forceinline__ const float* in_ptr(const Args& a, int i) { asm volatile("" : "+s"(i)); return a.in[i]; }

__device__ __forceinline__ void p0_item(const float* W, int K, int N, bf16_t* WT, const float* scale, int rmap  , LAS float* scr, int item, int lane) {
    const int nblk = N / 32, kb = item / nblk, nb = item % nblk, k0 = 64 * kb, n0 = 32 * nb;
    float wv[32];
#pragma unroll
    for (int i = 0; i < 32; ++i) wv[i] = W[(size_t)(k0 + 2 * i + (lane >> 5)) * N + n0 + (lane & 31)];
    if (scale) {
#pragma unroll
        for (int i = 0; i < 32; ++i) wv[i] *= scale[k0 + 2 * i + (lane >> 5)]; }
#pragma unroll
    for (int i = 0; i < 32; ++i) scr[(2 * i + (lane >> 5)) * 33 + (lane & 31)] = wv[i];
    LDS_WAIT();
    const int c = lane & 7;
#pragma unroll
    for (int j = 0; j < 4; ++j) { const int n = (lane >> 3) + 8 * j; const LAS float* s = scr + (8 * c) * 33 + n;
        u32x4 o; o.x = pk2(s[0 * 33], s[1 * 33]); o.y = pk2(s[2 * 33], s[3 * 33]); o.z = pk2(s[4 * 33], s[5 * 33]); o.w = pk2(s[6 * 33], s[7 * 33]);
        int row = n0 + n;
        if (rmap == 1) { const int bj = row >= DFF ? 1 : 0, ch = row - DFF * bj; row = 256 * (ch >> 7) + 128 * bj + (ch & 127); }
        else if (rmap == 2) row = proj_col_of(row);
        *(u32x4*)(WT + (size_t)row * K + k0 + 8 * c) = o; }
    LDS_WAIT();
}

__device__ __forceinline__ void p0_prologue(const Args& a, unsigned char* ws, LAS unsigned char* lds, const int tid) {
    const int lane = tid & 63, wave = tid >> 6;
    const int G = gridDim.x, gw = blockIdx.x * 8 + wave, NGW = G * 8;
    LAS float* scr = (LAS float*)(lds + wave * 16384);
    constexpr int I_IN = 16 * (NIN / 32), I_OUT = 16 * (DM / 32), I_UP = 16 * (NUP / 32), I_DN = (DFF / 64) * (DM / 32);
    constexpr int PER_L = I_IN + I_OUT + I_UP + I_DN;
    for (int it = gw; it < 2 * PER_L; it += NGW) {
        const int l = it / PER_L; int r = it % PER_L;
        if (r < I_IN) { p0_item(in_ptr(a, I_WIN) + (size_t)l * DM * NIN, DM, NIN, (bf16_t*)(ws + WS_WIN) + (size_t)l * NIN * DM, in_ptr(a, I_N1) + l * DM, 2, scr, r, lane); continue; } r -= I_IN;
        if (r < I_OUT) { p0_item(in_ptr(a, I_WOUT) + (size_t)l * DM * DM, DM, DM, (bf16_t*)(ws + WS_WOUT) + (size_t)l * DM * DM, nullptr, 0, scr, r, lane); continue; } r -= I_OUT;
        if (r < I_UP) { p0_item(in_ptr(a, I_WUP) + (size_t)l * DM * NUP, DM, NUP, (bf16_t*)(ws + WS_WUP) + (size_t)l * NUP * DM, in_ptr(a, I_N2) + l * DM, 1, scr, r, lane); continue; } r -= I_UP;
        p0_item(in_ptr(a, I_WDN) + (size_t)l * DFF * DM, DFF, DM, (bf16_t*)(ws + WS_WDN) + (size_t)l * DM * DFF, nullptr, 0, scr, r, lane);
    }
    {
        const float* x = in_ptr(a, I_X); bf16_t* xb = (bf16_t*)(ws + WS_XB); float* ssq = (float*)(ws + WS_SSQ);
        for (int m0 = 2 * gw; m0 < MROWS; m0 += 2 * NGW) {
            f32x4 v[2][4]; float s2[2];
#pragma unroll
            for (int r = 0; r < 2; ++r) { const f32x4* xr = (const f32x4*)(x + (size_t)(m0 + r) * DM) + lane;
#pragma unroll
                for (int j = 0; j < 4; ++j) v[r][j] = xr[64 * j]; }
#pragma unroll
            for (int r = 0; r < 2; ++r) { float s = 0.f;
#pragma unroll
                for (int j = 0; j < 4; ++j) s += (v[r][j][0] * v[r][j][0] + v[r][j][1] * v[r][j][1]) + (v[r][j][2] * v[r][j][2] + v[r][j][3] * v[r][j][3]);
#pragma unroll
                for (int o = 1; o < 64; o <<= 1) s += bperm_f(lane ^ o, s);
                s2[r] = s; }
#pragma unroll
            for (int r = 0; r < 2; ++r) { unsigned long long* o8 = (unsigned long long*)(xb + (size_t)(m0 + r) * DM) + lane;
#pragma unroll
                for (int j = 0; j < 4; ++j) o8[64 * j] = (unsigned long long)pk2(v[r][j][0], v[r][j][1]) | ((unsigned long long)pk2(v[r][j][2], v[r][j][3]) << 32);
                if (lane < 16) ssq[(size_t)(m0 + r) * 16 + lane] = lane == 0 ? s2[r] : 0.f; }
        }
    }
    {
        const int gt = blockIdx.x * NTHREADS + tid, NT = G * NTHREADS;
        float* cosT = (float*)(ws + WS_ROPE); float* sinT = cosT + SEQ * 32;
        for (int idx = gt; idx < SEQ * 32; idx += NT) { const int pos = idx >> 5, i = idx & 31;
            const float inv = powf(10000.0f, -(float)(2 * i) / 64.0f); const float ang = (float)pos * inv; float s, c; sincosf(ang, &s, &c); cosT[idx] = c; sinT[idx] = s; }
        bf16_t* gw_ = (bf16_t*)(ws + WS_GATE);
        const float* wa_ = in_ptr(a, I_WA); const float* wx_ = in_ptr(a, I_WX);
        for (int idx = gt; idx < 2 * 2 * 8 * 4096; idx += NT) { const int i = idx & 63, jj = (idx >> 6) & 63, h = (idx >> 12) & 7, ax = (idx >> 15) & 1, l = idx >> 16;
            const float* src = (ax ? wx_ : wa_) + (size_t)l * 8 * 4096 + h * 4096 + i * 64 + jj; gw_[idx] = (bf16_t)f2bf(*src); }
    }
}

constexpr int LD = 72;
constexpr int TILE_B = 64 * LD * 2;
__device__ __forceinline__ void mm64(f32x4 (&acc)[2], const LAS bf16_t* A, const LAS bf16_t* Bt, int wave, int lane) {
    const int rb = wave >> 1, cb0 = (wave & 1) * 2, fr = lane & 15, fq = lane >> 4;
#pragma unroll
    for (int kk = 0; kk < 2; ++kk) {
        const bf16x8 av = *(const LAS bf16x8*)(A + (16 * rb + fr) * LD + 32 * kk + 8 * fq);
#pragma unroll
        for (int t = 0; t < 2; ++t) {
            const bf16x8 bv = *(const LAS bf16x8*)(Bt + (16 * (cb0 + t) + fr) * LD + 32 * kk + 8 * fq);
            acc[t] = __builtin_amdgcn_mfma_f32_16x16x32_bf16(av, bv, acc[t], 0, 0, 0);
        }
    }
}

struct MixCtx {
    int l; unsigned char* ws; unsigned char* sb; LAS unsigned char* lds; int tid, lane, wave;
    const bf16_t* proj; bf16_t* y;
};

__device__ __forceinline__ float ret_lg(int h) { return log1pf(-exp2f(-5.0f - (float)h)); }

__device__ __forceinline__ float hg_lb(const Args& a, int l, int ch) {
    if (l == 0) return 0.f;
    const float* hb = in_ptr(a, I_HLB); return sigmoidf_(hb[256 + ch] - hb[ch]);
}

__device__ __forceinline__ void lru_m1(const Args& a, const MixCtx& c, int b, int ck_, int h) {
    const int l = c.l, tid = c.tid, lane = c.lane, wave = c.wave;
    LAS bf16_t* xcb = (LAS bf16_t*)c.lds;
    LAS float* xin = (LAS float*)(c.lds + 9216);
    LAS float* xcf = (LAS float*)(c.lds + 26368);
    LAS float* A_ = (LAS float*)(c.lds + 43008);
    LAS float* U_ = (LAS float*)(c.lds + 59648);
    const int row0 = b * SEQ + 64 * ck_;
    for (int idx = tid; idx < 67 * 8; idx += NTHREADS) { const int r = idx >> 3, q = idx & 7, t = 64 * ck_ - 3 + r; float v[8];
#pragma unroll
        for (int i = 0; i < 8; ++i) v[i] = 0.f;
        if (t >= 0) ld8bf(c.proj + (size_t)(b * SEQ + t) * NIN + C_LX + 64 * h + 8 * q, v);
#pragma unroll
        for (int i = 0; i < 8; ++i) xin[r * 64 + 8 * q + i] = v[i]; }
    __syncthreads();
    {
        const float* cw = in_ptr(a, I_LCW) + (size_t)l * 4 * 512; const float* cbias = in_ptr(a, I_LCB) + l * 512;
        const int tok = tid >> 3, q = tid & 7; float v[8];
#pragma unroll
        for (int i = 0; i < 8; ++i) { const int ch = 64 * h + 8 * q + i; float s = cbias[ch];
#pragma unroll
            for (int k = 0; k < 4; ++k) s += cw[k * 512 + ch] * xin[(tok + k) * 64 + 8 * q + i];
            xcf[tok * 65 + 8 * q + i] = s; v[i] = s; }
        *(LAS u32x4*)(xcb + tok * LD + 8 * q) = pack8(v);
    }
    __syncthreads();
    {
        const bf16_t* gwt = (const bf16_t*)(c.ws + WS_GATE) + (size_t)l * 65536;
        const bf16_t* waT = gwt + h * 4096; const bf16_t* wxT = gwt + 32768 + h * 4096;
        const int rb = wave >> 1, cb0 = (wave & 1) * 2, fr = lane & 15, fq = lane >> 4;
        f32x4 ga[2], gx[2];
#pragma unroll
        for (int t = 0; t < 2; ++t) { ga[t] = (f32x4){0.f, 0.f, 0.f, 0.f}; gx[t] = (f32x4){0.f, 0.f, 0.f, 0.f}; }
#pragma unroll
        for (int kk = 0; kk < 2; ++kk) {
            const bf16x8 av = *(const LAS bf16x8*)(xcb + (16 * rb + fr) * LD + 32 * kk + 8 * fq);
#pragma unroll
            for (int t = 0; t < 2; ++t) { const int jj = 16 * (cb0 + t) + fr;
                const bf16x8 ba_ = *(const bf16x8*)(waT + jj * 64 + 32 * kk + 8 * fq), bx_ = *(const bf16x8*)(wxT + jj * 64 + 32 * kk + 8 * fq);
                ga[t] = __builtin_amdgcn_mfma_f32_16x16x32_bf16(av, ba_, ga[t], 0, 0, 0);
                gx[t] = __builtin_amdgcn_mfma_f32_16x16x32_bf16(av, bx_, gx[t], 0, 0, 0); }
        }
        const float* ba = in_ptr(a, I_BA) + l * 512; const float* bx = in_ptr(a, I_BX) + l * 512; const float* lam = in_ptr(a, I_LAM) + l * 512;
#pragma unroll
        for (int t = 0; t < 2; ++t) { const int jj = 16 * (cb0 + t) + fr, ch = 64 * h + jj;
            const float bav = ba[ch], bxv = bx[ch], sp = log1pf(__expf(-lam[ch]));
#pragma unroll
            for (int r = 0; r < 4; ++r) { const int tok = 16 * rb + 4 * fq + r;
                const float rg = sigmoidf_(ga[t][r] + bav), ig = sigmoidf_(gx[t][r] + bxv);
                const float la = -8.0f * rg * sp; const float av_ = __expf(la);
                const float uv = sqrtf(-expm1f(2.0f * la)) * (ig * xcf[tok * 65 + jj]);
                A_[tok * 65 + jj] = av_; U_[tok * 65 + jj] = uv; }
        }
    }
    __syncthreads();
    if (tid < 64) { float hh = 0.f, P = 1.f;
        for (int t = 0; t < 64; ++t) { const float av_ = A_[t * 65 + tid], uv = U_[t * 65 + tid]; hh = av_ * hh + uv; P *= av_; U_[t * 65 + tid] = hh; A_[t * 65 + tid] = P; }
        const size_t so = (size_t)(b * NCH + ck_) * 512 + 64 * h + tid;
        ((float*)(c.ws + WS_LRUA))[so] = P; ((float*)(c.ws + WS_LRUH))[so] = hh; }
    __syncthreads();
    { const int tok = tid >> 3, q = tid & 7; float hv[8], pv[8];
#pragma unroll
        for (int i = 0; i < 8; ++i) { hv[i] = U_[tok * 65 + 8 * q + i]; pv[i] = A_[tok * 65 + 8 * q + i]; }
        *(u32x4*)(c.y + (size_t)(row0 + tok) * DM + 64 * h + 8 * q) = pack8(hv);
        *(u32x4*)((bf16_t*)(c.ws + WS_P) + (size_t)(row0 + tok) * 512 + 64 * h + 8 * q) = pack8(pv); }
    __syncthreads();
}

__device__ __forceinline__ void lru_m3(const MixCtx& c, int b, int ck_, int h) {
    const int tok = c.tid >> 3, q = c.tid & 7, row = b * SEQ + 64 * ck_ + tok, col = 64 * h + 8 * q;
    float hl[8], pv[8], g[8], o[8];
    ld8bf(c.y + (size_t)row * DM + col, hl); ld8bf((const bf16_t*)(c.ws + WS_P) + (size_t)row * 512 + col, pv); ld8bf(c.proj + (size_t)row * NIN + C_LG + col, g);
    const float* hin = (const float*)(c.ws + WS_LRUIN) + (size_t)(b * NCH + ck_) * 512 + col;
#pragma unroll
    for (int i = 0; i < 8; ++i) o[i] = (hl[i] + pv[i] * hin[i]) * gelu_tanh(g[i]);
    *(u32x4*)(c.y + (size_t)row * DM + col) = pack8(o);
}

__device__ __forceinline__ void rot8(const MixCtx& c, const bf16_t* src, int pos, int cp, float (&o1)[8], float (&o2)[8]) {
    float x1[8], x2[8]; ld8bf(src + 8 * cp, x1); ld8bf(src + 32 + 8 * cp, x2);
    const float* cosT = (const float*)(c.ws + WS_ROPE) + pos * 32 + 8 * cp; const float* sinT = cosT + SEQ * 32;
#pragma unroll
    for (int i = 0; i < 8; ++i) { const float cs = cosT[i], sn = sinT[i]; o1[i] = x1[i] * cs - x2[i] * sn; o2[i] = x2[i] * cs + x1[i] * sn; }
}
__device__ __forceinline__ void store_vT(const MixCtx& c, LAS bf16_t* vT, int row0, int vcol) {
    const int r = c.tid >> 3, q = c.tid & 7; const u32x4 w = *(const u32x4*)(c.proj + (size_t)(row0 + r) * NIN + vcol + 8 * q);
    const unsigned ww[4] = {w.x, w.y, w.z, w.w};
#pragma unroll
    for (int i = 0; i < 8; ++i) vT[(8 * q + i) * LD + r] = (bf16_t)((ww[i >> 1] >> (16 * (i & 1))) & 0xffffu);
}
__device__ __forceinline__ void store_state(f32x4 (&acc)[2], float* S, int wave, int lane) {
    const int rb = wave >> 1, cb0 = (wave & 1) * 2, fr = lane & 15, fq = lane >> 4;
#pragma unroll
    for (int t = 0; t < 2; ++t)
#pragma unroll
        for (int r = 0; r < 4; ++r) S[(16 * rb + 4 * fq + r) * 64 + 16 * (cb0 + t) + fr] = acc[t][r];
}

__device__ __forceinline__ void ret_m1(const MixCtx& c, int b, int ck_, int h) {
    LAS bf16_t* kdT = (LAS bf16_t*)c.lds; LAS bf16_t* vT = (LAS bf16_t*)(c.lds + TILE_B);
    const int row0 = b * SEQ + 64 * ck_;
    if (c.tid < 256) { const int r = c.tid >> 2, cp = c.tid & 3; float o1[8], o2[8];
        rot8(c, c.proj + (size_t)(row0 + r) * NIN + C_RK + 64 * h, 64 * ck_ + r, cp, o1, o2);
        const float sc = 0.125f * __expf((float)(63 - r) * ret_lg(h));
#pragma unroll
        for (int i = 0; i < 8; ++i) { kdT[(8 * cp + i) * LD + r] = (bf16_t)f2bf(o1[i] * sc); kdT[(32 + 8 * cp + i) * LD + r] = (bf16_t)f2bf(o2[i] * sc); } }
    store_vT(c, vT, row0, C_RV + 64 * h);
    __syncthreads();
    f32x4 acc[2] = {(f32x4){0.f, 0.f, 0.f, 0.f}, (f32x4){0.f, 0.f, 0.f, 0.f}};
    mm64(acc, vT, kdT, c.wave, c.lane);
    store_state(acc, (float*)(c.ws + WS_SRET) + (size_t)((b * NCH + ck_) * 4 + h) * 4096, c.wave, c.lane);
    __syncthreads();
}

__device__ __forceinline__ void hg_fk(const Args& a, const MixCtx& c, int row, int h, int q, LAS float* LF, int r, float (&kk)[8]) {
    float fp[8]; ld8bf(c.proj + (size_t)row * NIN + C_HF + 64 * h + 8 * q, fp);
#pragma unroll
    for (int i = 0; i < 8; ++i) { const float lb = hg_lb(a, c.l, 64 * h + 8 * q + i);
        const float e = __expf(-fabsf(fp[i]));
        const float sp = fp[i] >= 0.f ? 1.0f / (1.0f + e) : e / (1.0f + e);
        const float sn = fp[i] >= 0.f ? e / (1.0f + e) : 1.0f / (1.0f + e);
        const float lsig = (fp[i] >= 0.f ? 0.f : fp[i]) - log1pf(e);
        const float lf = (lb == 0.f) ? lsig : __logf(lb + (1.0f - lb) * sp);
        LF[r * 65 + 8 * q + i] = lf; kk[i] = (1.0f - lb) * sn; }
}
__device__ __forceinline__ void hg_cumsum(LAS float* LF, int tid) {
    if (tid < 64) { float run = 0.f; for (int m = 0; m < 64; ++m) { run += LF[m * 65 + tid]; LF[m * 65 + tid] = run; } }
}

__device__ __forceinline__ void hg_m1(const Args& a, const MixCtx& c, int b, int ck_, int h) {
    LAS bf16_t* kbT = (LAS bf16_t*)c.lds; LAS bf16_t* vT = (LAS bf16_t*)(c.lds + TILE_B); LAS float* LF = (LAS float*)(c.lds + 6 * TILE_B);
    const int row0 = b * SEQ + 64 * ck_, r = c.tid >> 3, q = c.tid & 7; float kk[8];
    hg_fk(a, c, row0 + r, h, q, LF, r, kk);
    store_vT(c, vT, row0, C_HI + 64 * h);
    __syncthreads();
    hg_cumsum(LF, c.tid);
    __syncthreads();
    if (c.tid < 64) ((float*)(c.ws + WS_HGDEC))[(size_t)((b * NCH + ck_) * 4 + h) * 64 + c.tid] = __expf(LF[63 * 65 + c.tid]);
#pragma unroll
    for (int i = 0; i < 8; ++i) { const int d = 8 * q + i; kbT[d * LD + r] = (bf16_t)f2bf(kk[i] * __expf(LF[63 * 65 + d] - LF[r * 65 + d])); }
    __syncthreads();
    f32x4 acc[2] = {(f32x4){0.f, 0.f, 0.f, 0.f}, (f32x4){0.f, 0.f, 0.f, 0.f}};
    mm64(acc, vT, kbT, c.wave, c.lane);
    store_state(acc, (float*)(c.ws + WS_SHG) + (size_t)((b * NCH + ck_) * 4 + h) * 4096, c.wave, c.lane);
    __syncthreads();
}

template <int KIND>
__device__ __forceinline__ void mix_m3(const Args& a, const MixCtx& c, int b, int ck_, int h) {
    const int tid = c.tid, lane = c.lane, wave = c.wave;
    LAS bf16_t* qr = (LAS bf16_t*)c.lds; LAS bf16_t* kr = (LAS bf16_t*)(c.lds + TILE_B); LAS bf16_t* qd = (LAS bf16_t*)(c.lds + 2 * TILE_B);
    LAS bf16_t* vT = (LAS bf16_t*)(c.lds + 3 * TILE_B); LAS bf16_t* ST = (LAS bf16_t*)(c.lds + 4 * TILE_B); LAS bf16_t* Pm = (LAS bf16_t*)(c.lds + 5 * TILE_B);
    LAS float* LF = (LAS float*)(c.lds + 6 * TILE_B);
    LAS float* OB = (LAS float*)(c.lds + 6 * TILE_B + 16640);
    const int row0 = b * SEQ + 64 * ck_;
    const float lg = ret_lg(h);
    const float* Sg = (const float*)(c.ws + (KIND == 0 ? WS_SRET : WS_SHG)) + (size_t)((b * NCH + ck_) * 4 + h) * 4096;
    { const int e = tid >> 3, q = tid & 7; const f32x4 s0 = *(const f32x4*)(Sg + e * 64 + 8 * q), s1 = *(const f32x4*)(Sg + e * 64 + 8 * q + 4);
      u32x4 w; w.x = pk2(s0[0], s0[1]); w.y = pk2(s0[2], s0[3]); w.z = pk2(s1[0], s1[1]); w.w = pk2(s1[2], s1[3]); *(LAS u32x4*)(ST + e * LD + 8 * q) = w; }
    store_vT(c, vT, row0, (KIND == 0 ? C_RV : C_HI) + 64 * h);
    if (KIND == 0) {
        const int half = tid >> 8, r = (tid & 255) >> 2, cp = tid & 3; float o1[8], o2[8];
        rot8(c, c.proj + (size_t)(row0 + r) * NIN + (half ? C_RK : C_RQ) + 64 * h, 64 * ck_ + r, cp, o1, o2);
        if (half == 0) {
            *(LAS u32x4*)(qr + r * LD + 8 * cp) = pack8(o1); *(LAS u32x4*)(qr + r * LD + 32 + 8 * cp) = pack8(o2);
            const float sc = __expf((float)(r + 1) * lg);
#pragma unroll
            for (int i = 0; i < 8; ++i) { o1[i] *= sc; o2[i] *= sc; }
            *(LAS u32x4*)(qd + r * LD + 8 * cp) = pack8(o1); *(LAS u32x4*)(qd + r * LD + 32 + 8 * cp) = pack8(o2);
        } else {
#pragma unroll
            for (int i = 0; i < 8; ++i) { o1[i] *= 0.125f; o2[i] *= 0.125f; }
            *(LAS u32x4*)(kr + r * LD + 8 * cp) = pack8(o1); *(LAS u32x4*)(kr + r * LD + 32 + 8 * cp) = pack8(o2);
        }
    } else {
        const int r = tid >> 3, q = tid & 7; float kk[8], qv[8];
        hg_fk(a, c, row0 + r, h, q, LF, r, kk);
        ld8bf(c.proj + (size_t)(row0 + r) * NIN + C_HQ + 64 * h + 8 * q, qv);
#pragma unroll
        for (int i = 0; i < 8; ++i) qv[i] = qv[i] * sigmoidf_(qv[i]);
        __syncthreads();
        hg_cumsum(LF, tid);
        __syncthreads();
        float a1[8], a2[8], a3[8];
#pragma unroll
        for (int i = 0; i < 8; ++i) { const int d = 8 * q + i; const float bn = LF[r * 65 + d], rf = LF[31 * 65 + d];
            a1[i] = qv[i] * __expf(bn - rf); a2[i] = kk[i] * __expf(rf - bn); a3[i] = qv[i] * __expf(bn); }
        *(LAS u32x4*)(qr + r * LD + 8 * q) = pack8(a1); *(LAS u32x4*)(kr + r * LD + 8 * q) = pack8(a2); *(LAS u32x4*)(qd + r * LD + 8 * q) = pack8(a3);
    }
    __syncthreads();
    const int rb = wave >> 1, cb0 = (wave & 1) * 2, fr = lane & 15, fq = lane >> 4;
    {
        f32x4 sc[2] = {(f32x4){0.f, 0.f, 0.f, 0.f}, (f32x4){0.f, 0.f, 0.f, 0.f}};
        mm64(sc, qr, kr, wave, lane);
#pragma unroll
        for (int t = 0; t < 2; ++t)
#pragma unroll
            for (int r = 0; r < 4; ++r) { const int n = 16 * rb + 4 * fq + r, m = 16 * (cb0 + t) + fr; float v = sc[t][r];
                if (KIND == 0) v *= __expf((float)(n - m) * lg);
                v = (m <= n) ? v : 0.f;
                Pm[n * LD + m] = (bf16_t)f2bf(v); }
    }
    __syncthreads();
    {
        f32x4 o[2] = {(f32x4){0.f, 0.f, 0.f, 0.f}, (f32x4){0.f, 0.f, 0.f, 0.f}};
        mm64(o, Pm, vT, wave, lane);
        mm64(o, qd, ST, wave, lane);
#pragma unroll
        for (int t = 0; t < 2; ++t)
#pragma unroll
            for (int r = 0; r < 4; ++r) OB[(16 * rb + 4 * fq + r) * 68 + 16 * (cb0 + t) + fr] = o[t][r];
    }
    __syncthreads();
    {
        const int n = tid >> 3, q = tid & 7, row = row0 + n; float v[8], g[8]; float ss = 0.f;
#pragma unroll
        for (int i = 0; i < 8; ++i) { v[i] = OB[n * 68 + 8 * q + i]; ss += v[i] * v[i]; }
        ss += bperm_f(lane ^ 1, ss); ss += bperm_f(lane ^ 2, ss); ss += bperm_f(lane ^ 4, ss);
        const float rs = rsqrtf(ss * (1.0f / 64.0f) + EPS);
        ld8bf(c.proj + (size_t)row * NIN + (KIND == 0 ? C_RG : C_HG) + 64 * h + 8 * q, g);
        const float* nw = in_ptr(a, KIND == 0 ? I_RNW : I_HNW) + c.l * 256 + 64 * h + 8 * q;
#pragma unroll
        for (int i = 0; i < 8; ++i) v[i] = v[i] * rs * nw[i] * (g[i] * sigmoidf_(g[i]));
        *(u32x4*)(c.y + (size_t)row * DM + (KIND == 0 ? 512 : 768) + 64 * h + 8 * q) = pack8(v);
    }
    __syncthreads();
}

constexpr int WLDS = 18432;
constexpr size_t OUT_SBR = 0;
constexpr size_t OUT_SBH = 16 * MiB;
#define WAVE_LDS_FENCE() asm volatile("s_waitcnt lgkmcnt(0)" ::: "memory")
__device__ __forceinline__ bf16x8 pack_frag(const float (&v)[8]) { return __builtin_bit_cast(bf16x8, pack8(v)); }
template <int N> __device__ __forceinline__ float dpp_shr0(float v) {
    return __builtin_bit_cast(float, __builtin_amdgcn_update_dpp(0, __builtin_bit_cast(int, v), 0x110 + N, 0xf, 0xf, true)); }
template <int N> __device__ __forceinline__ float dpp_shr1(float v) {
    return __builtin_bit_cast(float, __builtin_amdgcn_update_dpp(0x3f800000, __builtin_bit_cast(int, v), 0x110 + N, 0xf, 0xf, false)); }
__device__ __forceinline__ float row_sum_incl(float v) { v += dpp_shr0<1>(v); v += dpp_shr0<2>(v); v += dpp_shr0<4>(v); v += dpp_shr0<8>(v); return v; }
__device__ __forceinline__ float bcast15(float v, int lane) { return bperm_f((lane & 48) | 15, v); }

typedef short v4i16_t __attribute__((ext_vector_type(4)));
__device__ __forceinline__ unsigned long long tr4(const LAS bf16_t* T, int m0, int c0, int li) {
    const v4i16_t v = __builtin_amdgcn_ds_read_tr16_b64_v4i16((LAS v4i16_t*)(T + (m0 + (li >> 2)) * LD + c0 + 4 * (li & 3)));
    return __builtin_bit_cast(unsigned long long, v);
}
__device__ __forceinline__ bf16x8 tr_frag(const LAS bf16_t* T, int mA, int mB, int c0, int li) {
    const unsigned long long a = tr4(T, mA, c0, li), b = tr4(T, mB, c0, li);
    u32x4 w; w.x = (unsigned)a; w.y = (unsigned)(a >> 32); w.z = (unsigned)b; w.w = (unsigned)(b >> 32); return __builtin_bit_cast(bf16x8, w);
}
__device__ __forceinline__ void w_store_vT(LAS bf16_t* vN, const bf16_t* src, int lane) {
#pragma unroll
    for (int i = 0; i < 8; ++i) { const int m = (lane >> 3) + 8 * i, e0 = 8 * (lane & 7); *(LAS u32x4*)(vN + m * LD + e0) = *(const u32x4*)(src + (size_t)m * NIN + e0); }
}
__device__ __forceinline__ void w_kv(const LAS bf16_t* vN, const LAS bf16_t* kN, bf16_t* S, int lo, int fq) {
#pragma unroll
    for (int db = 0; db < 4; ++db) {
        bf16x8 kf[2];
#pragma unroll
        for (int kk = 0; kk < 2; ++kk) kf[kk] = tr_frag(kN, 32 * kk + 8 * fq, 32 * kk + 8 * fq + 4, 16 * db, lo);
#pragma unroll
        for (int eb = 0; eb < 4; ++eb) { f32x4 acc = {0.f, 0.f, 0.f, 0.f};
#pragma unroll
            for (int kk = 0; kk < 2; ++kk) { const bf16x8 vf = tr_frag(vN, 32 * kk + 8 * fq, 32 * kk + 8 * fq + 4, 16 * eb, lo); acc = __builtin_amdgcn_mfma_f32_16x16x32_bf16(kf[kk], vf, acc, 0, 0, 0); }
            *(unsigned long long*)(S + (16 * eb + lo) * 64 + 16 * db + 4 * fq) = (unsigned long long)pk2(acc[0], acc[1]) | ((unsigned long long)pk2(acc[2], acc[3]) << 32); }
    }
}

__device__ __forceinline__ void w_ret_m1(unsigned char* ws, const bf16_t* proj, LAS unsigned char* wl, int b, int ck_, int h, int lane) {
    LAS bf16_t* vT = (LAS bf16_t*)wl; LAS bf16_t* kT = (LAS bf16_t*)(wl + TILE_B);
    const int row0 = b * SEQ + 64 * ck_, lo = lane & 15, fq = lane >> 4; const float lg = ret_lg(h);
    const float* cosT = (const float*)(ws + WS_ROPE); const float* sinT = cosT + SEQ * 32;
#pragma unroll
    for (int i = 0; i < 4; ++i) { const int m = (lane >> 2) + 16 * i, cp = lane & 3; float x1[8], x2[8];
        const bf16_t* src = proj + (size_t)(row0 + m) * NIN + CR(h, 1); ld8bf(src + 8 * cp, x1); ld8bf(src + 32 + 8 * cp, x2);
        const float* cp_ = cosT + (64 * ck_ + m) * 32 + 8 * cp; const float* sp_ = sinT + (64 * ck_ + m) * 32 + 8 * cp;
        const float sc = 0.125f * __expf((float)(63 - m) * lg);
        float o1[8], o2[8];
#pragma unroll
        for (int j = 0; j < 8; ++j) { const float cs = cp_[j], sn = sp_[j]; o1[j] = (x1[j] * cs - x2[j] * sn) * sc; o2[j] = (x2[j] * cs + x1[j] * sn) * sc; }
        *(LAS u32x4*)(kT + m * LD + 8 * cp) = pack8(o1); *(LAS u32x4*)(kT + m * LD + 32 + 8 * cp) = pack8(o2); }
    w_store_vT(vT, proj + (size_t)row0 * NIN + CR(h, 2), lane);
    WAVE_LDS_FENCE();
    w_kv(vT, kT, (bf16_t*)(ws + WS_SRET) + (size_t)((b * NCH + ck_) * 4 + h) * 4096, lo, fq);
    WAVE_LDS_FENCE();
}

template <int KIND>
__device__ __forceinline__ void w_m3_core(const bf16x8 (&Qf)[4][2], const bf16x8 (&Kf)[4][2], const bf16x8 (&Sf)[4][2], const LAS bf16_t* vT, float lg,
                                          const bf16_t* gsrc, const float* nw, bf16_t* ydst, int lo, int fq) {
#pragma unroll
    for (int nb = 0; nb < 4; ++nb) {
        f32x4 O[4], O2[4];
#pragma unroll
        for (int eb = 0; eb < 4; ++eb) { O[eb] = (f32x4){0.f, 0.f, 0.f, 0.f}; O2[eb] = (f32x4){0.f, 0.f, 0.f, 0.f}; }
#pragma unroll
        for (int kk2 = 0; kk2 < 2; ++kk2) {
            if (2 * kk2 > nb) continue;
            float pv[8];
#pragma unroll
            for (int hh = 0; hh < 2; ++hh) { const int mb = 2 * kk2 + hh;
                if (mb <= nb) { f32x4 s = {0.f, 0.f, 0.f, 0.f};
                    s = __builtin_amdgcn_mfma_f32_16x16x32_bf16(Kf[mb][0], Qf[nb][0], s, 0, 0, 0); s = __builtin_amdgcn_mfma_f32_16x16x32_bf16(Kf[mb][1], Qf[nb][1], s, 0, 0, 0);
#pragma unroll
                    for (int r = 0; r < 4; ++r) { const int m = 16 * mb + 4 * fq + r, n = 16 * nb + lo; float v = s[r];
                        if (KIND == 0) v *= __expf((float)(n - m) * lg);
                        if (mb == nb) v = (m <= n) ? v : 0.f;
                        pv[4 * hh + r] = v; }
                } else {
#pragma unroll
                    for (int r = 0; r < 4; ++r) pv[4 * hh + r] = 0.f; }
            }
            const bf16x8 Pf = pack_frag(pv);
#pragma unroll
            for (int eb = 0; eb < 4; ++eb)
                O[eb] = __builtin_amdgcn_mfma_f32_16x16x32_bf16(tr_frag(vT, 32 * kk2 + 4 * fq, 32 * kk2 + 16 + 4 * fq, 16 * eb, lo), Pf, O[eb], 0, 0, 0);
        }
#pragma unroll
        for (int kk = 0; kk < 2; ++kk)
#pragma unroll
            for (int eb = 0; eb < 4; ++eb) O2[eb] = __builtin_amdgcn_mfma_f32_16x16x32_bf16(Sf[eb][kk], Qf[nb][kk], O2[eb], 0, 0, 0);
        const float osc = KIND == 0 ? __expf((float)(16 * nb + lo + 1) * lg) : 1.0f;
#pragma unroll
        for (int eb = 0; eb < 4; ++eb) O[eb] = O[eb] + O2[eb] * osc;
        float ss = 0.f;
#pragma unroll
        for (int eb = 0; eb < 4; ++eb) ss += (O[eb][0] * O[eb][0] + O[eb][1] * O[eb][1]) + (O[eb][2] * O[eb][2] + O[eb][3] * O[eb][3]);
        { const int ln = (fq << 4) | lo; ss += bperm_f(ln ^ 16, ss); ss += bperm_f(ln ^ 32, ss); }
        const float rs = rsqrtf(ss * (1.0f / 64.0f) + EPS);
        const size_t n = 16 * nb + lo;
#pragma unroll
        for (int eb = 0; eb < 4; ++eb) { const int e0 = 16 * eb + 4 * fq;
            const unsigned long long gw_ = *(const unsigned long long*)(gsrc + n * NIN + e0); const f32x4 w4 = *(const f32x4*)(nw + e0);
            const float g0 = __uint_as_float((unsigned)gw_ << 16), g1 = __uint_as_float((unsigned)gw_ & 0xffff0000u), g2 = __uint_as_float((unsigned)(gw_ >> 32) << 16), g3 = __uint_as_float((unsigned)(gw_ >> 32) & 0xffff0000u);
            const float o0 = O[eb][0] * rs * w4[0] * (g0 * sigmoidf_(g0)), o1 = O[eb][1] * rs * w4[1] * (g1 * sigmoidf_(g1));
            const float o2 = O[eb][2] * rs * w4[2] * (g2 * sigmoidf_(g2)), o3 = O[eb][3] * rs * w4[3] * (g3 * sigmoidf_(g3));
            *(unsigned long long*)(ydst + n * DM + e0) = (unsigned long long)pk2(o0, o1) | ((unsigned long long)pk2(o2, o3) << 32); }
        asm volatile("" ::: "memory");
        __builtin_amdgcn_sched_barrier(0);
    }
}

__device__ __forceinline__ void w_ret_m3(const Args& a, int l, unsigned char* ws, const bf16_t* proj, bf16_t* y, LAS unsigned char* wl, int b, int ck_, int h, int lane) {
    LAS bf16_t* vT = (LAS bf16_t*)wl;
    const int row0 = b * SEQ + 64 * ck_, lo = lane & 15, fq = lane >> 4; const float lg = ret_lg(h);
    const float* cosT = (const float*)(ws + WS_ROPE); const float* sinT = cosT + SEQ * 32;
    w_store_vT(vT, proj + (size_t)row0 * NIN + CR(h, 2), lane);
    bf16x8 Qf[4][2], Kf[4][2], Sf[4][2];
#pragma unroll
    for (int tb = 0; tb < 4; ++tb) { const int n = 16 * tb + lo; float x1[8], x2[8], o1[8], o2[8], cs[8], sn[8];
        const float* cp_ = cosT + (64 * ck_ + n) * 32 + 8 * fq; const float* sp_ = sinT + (64 * ck_ + n) * 32 + 8 * fq;
#pragma unroll
        for (int j = 0; j < 8; ++j) { cs[j] = cp_[j]; sn[j] = sp_[j]; }
        const bf16_t* qs = proj + (size_t)(row0 + n) * NIN + CR(h, 0) + 8 * fq;
        ld8bf(qs, x1); ld8bf(qs + 32, x2);
#pragma unroll
        for (int j = 0; j < 8; ++j) { o1[j] = x1[j] * cs[j] - x2[j] * sn[j]; o2[j] = x2[j] * cs[j] + x1[j] * sn[j]; }
        Qf[tb][0] = pack_frag(o1); Qf[tb][1] = pack_frag(o2);
        const bf16_t* ks = proj + (size_t)(row0 + n) * NIN + CR(h, 1) + 8 * fq;
        ld8bf(ks, x1); ld8bf(ks + 32, x2);
#pragma unroll
        for (int j = 0; j < 8; ++j) { o1[j] = (x1[j] * cs[j] - x2[j] * sn[j]) * 0.125f; o2[j] = (x2[j] * cs[j] + x1[j] * sn[j]) * 0.125f; }
        Kf[tb][0] = pack_frag(o1); Kf[tb][1] = pack_frag(o2);
    }
    const bf16_t* Sb = (const bf16_t*)((const unsigned char*)a.out + OUT_SBR) + (size_t)((b * NCH + ck_) * 4 + h) * 4096;
#pragma unroll
    for (int eb = 0; eb < 4; ++eb)
#pragma unroll
        for (int kk = 0; kk < 2; ++kk) Sf[eb][kk] = *(const bf16x8*)(Sb + (16 * eb + lo) * 64 + 32 * kk + 8 * fq);
    WAVE_LDS_FENCE();
    w_m3_core<0>(Qf, Kf, Sf, vT, lg, proj + (size_t)row0 * NIN + CR(h, 3), in_ptr(a, I_RNW) + l * 256 + 64 * h, y + (size_t)row0 * DM + 512 + 64 * h, lo, fq);
    WAVE_LDS_FENCE();
}
__device__ __forceinline__ void hg_lf_key(float fp, float lb, float& lf, float& key) {
    const float e = __expf(-fabsf(fp));
    const float rc = __builtin_amdgcn_rcpf(1.0f + e);
    const float sp = fp >= 0.f ? rc : e * rc;
    const float sn = fp >= 0.f ? e * rc : rc;
    const float lsig = (fp >= 0.f ? 0.f : fp) + __logf(rc);
    lf = (lb == 0.f) ? lsig : __logf(lb + (1.0f - lb) * sp); key = (1.0f - lb) * sn;
}
__device__ __forceinline__ void w_hg_scan(const float (&lbv)[8], const bf16_t* fsrc, int lane, float (&bb)[4][8], float (&r31)[8], float (&r63)[8]) {
    const int lo = lane & 15;
#pragma unroll
    for (int tb = 0; tb < 4; ++tb) { float fp[8]; ld8bf(fsrc + (size_t)(16 * tb + lo) * NIN, fp);
#pragma unroll
        for (int j = 0; j < 8; ++j) { float key; hg_lf_key(fp[j], lbv[j], bb[tb][j], key); } }
    float carry[8];
#pragma unroll
    for (int j = 0; j < 8; ++j) carry[j] = 0.f;
#pragma unroll
    for (int tb = 0; tb < 4; ++tb) {
#pragma unroll
        for (int j = 0; j < 8; ++j) { const float v = row_sum_incl(bb[tb][j]) + carry[j]; bb[tb][j] = v; carry[j] = bcast15(v, lane); if (tb == 1) r31[j] = carry[j]; if (tb == 3) r63[j] = carry[j]; }
        __builtin_amdgcn_sched_barrier(0);
    }
}

__device__ __forceinline__ void w_hg_m1(const Args& a, int l, unsigned char* ws, const bf16_t* proj, LAS unsigned char* wl, int b, int ck_, int h, int lane) {
    LAS bf16_t* vT = (LAS bf16_t*)wl; LAS bf16_t* kT = (LAS bf16_t*)(wl + TILE_B);
    const int row0 = b * SEQ + 64 * ck_, lo = lane & 15, fq = lane >> 4;
#pragma unroll
    for (int kk = 0; kk < 2; ++kk) { float bb[4][8], r31[8], r63[8], lbv[8];
#pragma unroll
        for (int j = 0; j < 8; ++j) lbv[j] = hg_lb(a, l, 64 * h + 32 * kk + 8 * fq + j);
        const bf16_t* fsrc = proj + (size_t)row0 * NIN + CH(h, 1) + 32 * kk + 8 * fq;
        w_hg_scan(lbv, fsrc, lane, bb, r31, r63);
#pragma unroll
        for (int tb = 0; tb < 4; ++tb) { float fp[8]; ld8bf(fsrc + (size_t)(16 * tb + lo) * NIN, fp);
            float kb[8];
#pragma unroll
            for (int j = 0; j < 8; ++j) { float lf, key; hg_lf_key(fp[j], lbv[j], lf, key); kb[j] = key * __expf(r63[j] - bb[tb][j]); }
            *(LAS u32x4*)(kT + (16 * tb + lo) * LD + 32 * kk + 8 * fq) = pack8(kb); }
        if (lo == 0) { float* dp = (float*)(ws + WS_HGDEC) + (size_t)((b * NCH + ck_) * 4 + h) * 64 + 32 * kk + 8 * fq;
#pragma unroll
            for (int j = 0; j < 8; ++j) dp[j] = __expf(r63[j]); }
        __builtin_amdgcn_sched_barrier(0);
    }
    w_store_vT(vT, proj + (size_t)row0 * NIN + CH(h, 2), lane);
    WAVE_LDS_FENCE();
    w_kv(vT, kT, (bf16_t*)(ws + WS_SHG) + (size_t)((b * NCH + ck_) * 4 + h) * 4096, lo, fq);
    WAVE_LDS_FENCE();
}

__device__ __forceinline__ void w_hg_m3(const Args& a, int l, unsigned char* ws, const bf16_t* proj, bf16_t* y, LAS unsigned char* wl, int b, int ck_, int h, int lane) {
    LAS bf16_t* vT = (LAS bf16_t*)wl;
    const int row0 = b * SEQ + 64 * ck_, lo = lane & 15, fq = lane >> 4;
    w_store_vT(vT, proj + (size_t)row0 * NIN + CH(h, 2), lane);
    bf16x8 Qf[4][2], Kf[4][2], Sf[4][2]; float er[2][8];
    const bf16_t* Sb = (const bf16_t*)((const unsigned char*)a.out + OUT_SBH) + (size_t)((b * NCH + ck_) * 4 + h) * 4096;
#pragma unroll
    for (int kk = 0; kk < 2; ++kk) { float bb[4][8], r31[8], r63[8], lbv[8];
#pragma unroll
        for (int j = 0; j < 8; ++j) lbv[j] = hg_lb(a, l, 64 * h + 32 * kk + 8 * fq + j);
        const bf16_t* fsrc = proj + (size_t)row0 * NIN + CH(h, 1) + 32 * kk + 8 * fq;
        w_hg_scan(lbv, fsrc, lane, bb, r31, r63);
#pragma unroll
        for (int tb = 0; tb < 4; ++tb) { float fp[8], qv[8], a1[8], a2[8];
            ld8bf(fsrc + (size_t)(16 * tb + lo) * NIN, fp); ld8bf(proj + (size_t)(row0 + 16 * tb + lo) * NIN + CH(h, 0) + 32 * kk + 8 * fq, qv);
#pragma unroll
            for (int j = 0; j < 8; ++j) { float lf, key; hg_lf_key(fp[j], lbv[j], lf, key);
                const float q = qv[j] * sigmoidf_(qv[j]); a1[j] = q * __expf(bb[tb][j] - r31[j]); a2[j] = key * __expf(r31[j] - bb[tb][j]); }
            Qf[tb][kk] = pack_frag(a1); Kf[tb][kk] = pack_frag(a2); }
#pragma unroll
        for (int j = 0; j < 8; ++j) er[kk][j] = __expf(r31[j]);
        __builtin_amdgcn_sched_barrier(0);
    }
#pragma unroll
    for (int kk = 0; kk < 2; ++kk)
#pragma unroll
        for (int eb = 0; eb < 4; ++eb) { float sv[8]; ld8bf(Sb + (16 * eb + lo) * 64 + 32 * kk + 8 * fq, sv);
#pragma unroll
            for (int j = 0; j < 8; ++j) sv[j] *= er[kk][j];
            Sf[eb][kk] = pack_frag(sv); }
    WAVE_LDS_FENCE();
    w_m3_core<1>(Qf, Kf, Sf, vT, 0.f, proj + (size_t)row0 * NIN + CH(h, 3), in_ptr(a, I_HNW) + l * 256 + 64 * h, y + (size_t)row0 * DM + 768 + 64 * h, lo, fq);
    WAVE_LDS_FENCE();
}

__device__ __forceinline__ void w_lru_m1(const Args& a, int l, unsigned char* ws, const bf16_t* proj, bf16_t* y, LAS unsigned char* wl, int b, int ck_, int h, int lane) {
    LAS float* xcf = (LAS float*)wl;
    const int row0 = b * SEQ + 64 * ck_, lo = lane & 15, fq = lane >> 4;
    const float* cw = in_ptr(a, I_LCW) + (size_t)l * 4 * 512; const float* cbias = in_ptr(a, I_LCB) + l * 512;
    const bf16_t* gwt = (const bf16_t*)(ws + WS_GATE) + (size_t)l * 65536;
    const bf16_t* waT = gwt + h * 4096; const bf16_t* wxT = gwt + 32768 + h * 4096;
    const float* ba = in_ptr(a, I_BA) + l * 512 + 64 * h; const float* bx = in_ptr(a, I_BX) + l * 512 + 64 * h; const float* lam = in_ptr(a, I_LAM) + l * 512 + 64 * h;
    bf16x8 nWa[2], nWx[2]; f32x4 nba, nbx, nlam;
#pragma unroll
    for (int kk = 0; kk < 2; ++kk) { nWa[kk] = *(const bf16x8*)(waT + lo * 64 + 32 * kk + 8 * fq); nWx[kk] = *(const bf16x8*)(wxT + lo * 64 + 32 * kk + 8 * fq); }
    nba = *(const f32x4*)(ba + 4 * fq); nbx = *(const f32x4*)(bx + 4 * fq); nlam = *(const f32x4*)(lam + 4 * fq);
    bf16x8 Xf[4][2];
#pragma unroll
    for (int kk = 0; kk < 2; ++kk) { const int ch0 = 64 * h + 32 * kk + 8 * fq; float w[4][8], bs[8];
#pragma unroll
        for (int j = 0; j < 8; ++j) { bs[j] = cbias[ch0 + j];
#pragma unroll
            for (int k = 0; k < 4; ++k) w[k][j] = cw[k * 512 + ch0 + j]; }
#pragma unroll
        for (int tb = 0; tb < 4; ++tb) { const int tok = 16 * tb + lo, t = 64 * ck_ + tok; float s[8];
#pragma unroll
            for (int j = 0; j < 8; ++j) s[j] = bs[j];
#pragma unroll
            for (int k = 0; k < 4; ++k) { const int tt = t - 3 + k; float x[8];
                ld8bf(proj + (size_t)(b * SEQ + (tt >= 0 ? tt : 0)) * NIN + CL(h, 0) + 32 * kk + 8 * fq, x);
#pragma unroll
                for (int j = 0; j < 8; ++j) s[j] += (tt >= 0 ? w[k][j] : 0.f) * x[j]; }
            Xf[tb][kk] = pack_frag(s);
#pragma unroll
            for (int j = 0; j < 8; ++j) xcf[tok * 65 + 32 * kk + 8 * fq + j] = s[j]; }
    }
    WAVE_LDS_FENCE();
#pragma unroll
    for (int jb = 0; jb < 4; ++jb) {
        bf16x8 WaF[2], WxF[2]; f32x4 pba, pbx, plam;
#pragma unroll
        for (int kk = 0; kk < 2; ++kk) { WaF[kk] = nWa[kk]; WxF[kk] = nWx[kk]; }
        pba = nba; pbx = nbx; plam = nlam;
        if (jb < 3) {
#pragma unroll
            for (int kk = 0; kk < 2; ++kk) { nWa[kk] = *(const bf16x8*)(waT + (16 * (jb + 1) + lo) * 64 + 32 * kk + 8 * fq); nWx[kk] = *(const bf16x8*)(wxT + (16 * (jb + 1) + lo) * 64 + 32 * kk + 8 * fq); }
            nba = *(const f32x4*)(ba + 16 * (jb + 1) + 4 * fq); nbx = *(const f32x4*)(bx + 16 * (jb + 1) + 4 * fq); nlam = *(const f32x4*)(lam + 16 * (jb + 1) + 4 * fq);
        }
        const int j0 = 16 * jb + 4 * fq;
        float bav[4], bxv[4], sp[4], hc[4], Pc[4];
#pragma unroll
        for (int r = 0; r < 4; ++r) { bav[r] = pba[r]; bxv[r] = pbx[r]; sp[r] = log1pf(__expf(-plam[r])); hc[r] = 0.f; Pc[r] = 1.f; }
#pragma unroll
        for (int tb = 0; tb < 4; ++tb) { const int tok = 16 * tb + lo;
            f32x4 ga = {0.f, 0.f, 0.f, 0.f}, gx = {0.f, 0.f, 0.f, 0.f};
#pragma unroll
            for (int kk = 0; kk < 2; ++kk) { ga = __builtin_amdgcn_mfma_f32_16x16x32_bf16(WaF[kk], Xf[tb][kk], ga, 0, 0, 0); gx = __builtin_amdgcn_mfma_f32_16x16x32_bf16(WxF[kk], Xf[tb][kk], gx, 0, 0, 0); }
            float hv[4], pv[4];
#pragma unroll
            for (int r = 0; r < 4; ++r) {
                const float rg = sigmoidf_(ga[r] + bav[r]), ig = sigmoidf_(gx[r] + bxv[r]);
                const float la = -8.0f * rg * sp[r]; float A = __expf(la);
                float U = __builtin_amdgcn_sqrtf(1.0f - A * A) * (ig * xcf[tok * 65 + j0 + r]);
                { const float As = dpp_shr1<1>(A), Us = dpp_shr0<1>(U); U = A * Us + U; A = A * As; }
                { const float As = dpp_shr1<2>(A), Us = dpp_shr0<2>(U); U = A * Us + U; A = A * As; }
                { const float As = dpp_shr1<4>(A), Us = dpp_shr0<4>(U); U = A * Us + U; A = A * As; }
                { const float As = dpp_shr1<8>(A), Us = dpp_shr0<8>(U); U = A * Us + U; A = A * As; }
                const float hh = U + A * hc[r], PP = A * Pc[r];
                hc[r] = bcast15(hh, lane); Pc[r] = bcast15(PP, lane); hv[r] = hh; pv[r] = PP; }
            *(unsigned long long*)(y + (size_t)(row0 + tok) * DM + 64 * h + j0) = (unsigned long long)pk2(hv[0], hv[1]) | ((unsigned long long)pk2(hv[2], hv[3]) << 32);
            *(unsigned long long*)((bf16_t*)(ws + WS_P) + (size_t)(row0 + tok) * 512 + 64 * h + j0) = (unsigned long long)pk2(pv[0], pv[1]) | ((unsigned long long)pk2(pv[2], pv[3]) << 32);
        }
        if (lo == 0) { const size_t so = (size_t)(b * NCH + ck_) * 512 + 64 * h + j0;
#pragma unroll
            for (int r = 0; r < 4; ++r) { ((float*)(ws + WS_LRUA))[so + r] = Pc[r]; ((float*)(ws + WS_LRUH))[so + r] = hc[r]; } }
    }
    WAVE_LDS_FENCE();
}
__device__ __forceinline__ void w_lru_m3(unsigned char* ws, const bf16_t* proj, bf16_t* y, int b, int ck_, int h, int lane) {
    const int q = lane & 7, col = 64 * h + 8 * q;
    const float* hinp = (const float*)(ws + WS_LRUIN) + (size_t)(b * NCH + ck_) * 512 + col;
    const f32x4 h0 = *(const f32x4*)hinp, h1 = *(const f32x4*)(hinp + 4);
    const float hin[8] = {h0[0], h0[1], h0[2], h0[3], h1[0], h1[1], h1[2], h1[3]};
#pragma unroll
    for (int i0 = 0; i0 < 8; i0 += 4) {
        u32x4 rh[4], rp[4], rg[4];
#pragma unroll
        for (int i = 0; i < 4; ++i) { const size_t row = (size_t)b * SEQ + 64 * ck_ + (lane >> 3) + 8 * (i0 + i);
            rh[i] = *(const u32x4*)(y + row * DM + col); rp[i] = *(const u32x4*)((const bf16_t*)(ws + WS_P) + row * 512 + col); rg[i] = *(const u32x4*)(proj + row * NIN + CL(h, 1) + 8 * q); }
#pragma unroll
        for (int i = 0; i < 4; ++i) { const size_t row = (size_t)b * SEQ + 64 * ck_ + (lane >> 3) + 8 * (i0 + i);
            float hl[8], pv[8], g[8], o[8]; unpack8(rh[i], hl); unpack8(rp[i], pv); unpack8(rg[i], g);
#pragma unroll
            for (int j = 0; j < 8; ++j) o[j] = (hl[j] + pv[j] * hin[j]) * gelu_tanh(g[j]);
            *(u32x4*)(y + row * DM + col) = pack8(o); }
    }
}

#ifndef WAVE_KINDS
#define WAVE_KINDS 7
#endif
__device__ __forceinline__ bool kind_is_wave(int k) { return (k < 8) ? ((WAVE_KINDS & 4) != 0) : (k < 12 ? ((WAVE_KINDS & 1) != 0) : ((WAVE_KINDS & 2) != 0)); }
template <int pass>
__device__ __forceinline__ void mix_phase(const Args& a, const MixCtx& c) {
    if (WAVE_KINDS != 7) {
        for (int su = blockIdx.x; su < BATCH * NCH * 16; su += gridDim.x) {
            const int bc = su >> 4, k = ((su & 15) + (su >> 8)) & 15, b = bc / NCH, ck_ = bc % NCH;
            if (kind_is_wave(k)) continue;
            if (pass == 1) { if (k < 8) { if (!(WAVE_KINDS & 4)) lru_m1(a, c, b, ck_, k); } else if (k < 12) { if (!(WAVE_KINDS & 1)) ret_m1(c, b, ck_, k - 8); } else { if (!(WAVE_KINDS & 2)) hg_m1(a, c, b, ck_, k - 12); } }
            else { if (k < 8) { if (!(WAVE_KINDS & 4)) lru_m3(c, b, ck_, k); } else if (k < 12) { if (!(WAVE_KINDS & 1)) mix_m3<0>(a, c, b, ck_, k - 8); } else { if (!(WAVE_KINDS & 2)) mix_m3<1>(a, c, b, ck_, k - 12); } }
        }
        __syncthreads();
    }
    const int wave = __builtin_amdgcn_readfirstlane(c.tid >> 6);
    LAS unsigned char* wl = c.lds + wave * WLDS;
#define WAVE_ITEM_LOOP(COND, CALL) do { \
        for (int it = blockIdx.x * 8 + wave; it < BATCH * NCH * 16; it += gridDim.x * 8) { \
            const int bc = it >> 4, k = ((it & 15) + (it >> 8) + 4 * (it >> 11)) & 15, b = bc / NCH, ck_ = bc % NCH; if (!(COND)) continue; \
            int lane = c.tid & 63; asm volatile("" : "+v"(lane)); CALL; } } while (0)
#pragma unroll 1
    for (int st = 0; st < 3; ++st) {
        const int kind = (st + (wave >> 2)) % 3;
        if (kind == 0) { if (pass == 1) WAVE_ITEM_LOOP(k >= 8 && k < 12, w_ret_m1(c.ws, c.proj, wl, b, ck_, k - 8, lane)); else WAVE_ITEM_LOOP(k >= 8 && k < 12, w_ret_m3(a, c.l, c.ws, c.proj, c.y, wl, b, ck_, k - 8, lane)); }
        else if (kind == 1) { if (pass == 1) WAVE_ITEM_LOOP(k >= 12, w_hg_m1(a, c.l, c.ws, c.proj, wl, b, ck_, k - 12, lane)); else WAVE_ITEM_LOOP(k >= 12, w_hg_m3(a, c.l, c.ws, c.proj, c.y, wl, b, ck_, k - 12, lane)); }
        else { if (pass == 1) WAVE_ITEM_LOOP(k < 8, w_lru_m1(a, c.l, c.ws, c.proj, c.y, wl, b, ck_, k, lane)); else WAVE_ITEM_LOOP(k < 8, w_lru_m3(c.ws, c.proj, c.y, b, ck_, k, lane)); }
    }
#ifdef DUP_M3
    if (pass == 3) { WAVE_ITEM_LOOP(k >= 8 && k < 12, w_ret_m3(a, c.l, c.ws, c.proj, c.y, wl, b, ck_, k - 8, lane)); WAVE_ITEM_LOOP(k >= 12, w_hg_m3(a, c.l, c.ws, c.proj, c.y, wl, b, ck_, k - 12, lane)); }
#endif
#undef WAVE_ITEM_LOOP
}

__device__ __forceinline__ void mix_m2(const MixCtx& c) {
    const int gt = blockIdx.x * NTHREADS + c.tid, NT = gridDim.x * NTHREADS;
    if ((c.tid >> 6) == 7 && (c.tid & 63) < 8) {
        for (int idx = blockIdx.x * 8 + (c.tid & 63); idx < BATCH * 512; idx += gridDim.x * 8) { const int b = idx >> 9, ch = idx & 511;
            const float* A = (const float*)(c.ws + WS_LRUA) + (size_t)b * NCH * 512 + ch; const float* H = (const float*)(c.ws + WS_LRUH) + (size_t)b * NCH * 512 + ch;
            float* HI = (float*)(c.ws + WS_LRUIN) + (size_t)b * NCH * 512 + ch; float hh = 0.f;
            for (int c0 = 0; c0 < NCH; c0 += 32) { float av[32], hv[32];
#pragma unroll
                for (int i = 0; i < 32; ++i) { av[i] = A[(c0 + i) * 512]; hv[i] = H[(c0 + i) * 512]; }
#pragma unroll
                for (int i = 0; i < 32; ++i) { HI[(c0 + i) * 512] = hh; hh = av[i] * hh + hv[i]; } } }
    }
    if (c.tid < 256)
    for (int idx = blockIdx.x * 256 + c.tid; idx < 2 * 32768; idx += gridDim.x * 256) {
        const int kind = idx >> 15, e = idx & 32767, b = e >> 13, h = (e >> 11) & 3, pr = e & 2047, ed = 2 * pr;
        const unsigned* S = (const unsigned*)(c.ws + (kind == 0 ? WS_SRET : WS_SHG)) + (size_t)(b * NCH * 4 + h) * 2048 + pr;
        unsigned* SB = (unsigned*)(c.sb + (kind == 0 ? OUT_SBR : OUT_SBH)) + (size_t)(b * NCH * 4 + h) * 2048 + pr;
        float s0 = 0.f, s1 = 0.f;
        if (kind == 0) { const float dec = __expf(64.0f * ret_lg(h));
            for (int c0 = 0; c0 < NCH; c0 += 64) { unsigned kv[64];
#pragma unroll
                for (int i = 0; i < 64; ++i) kv[i] = S[(size_t)(c0 + i) * 8192];
#pragma unroll
                for (int i = 0; i < 64; ++i) { SB[(size_t)(c0 + i) * 8192] = pk2(s0, s1); s0 = s0 * dec + __uint_as_float(kv[i] << 16); s1 = s1 * dec + __uint_as_float(kv[i] & 0xffff0000u); } }
        } else { const float* dp = (const float*)(c.ws + WS_HGDEC) + (size_t)(b * NCH * 4 + h) * 64 + (ed & 63);
            for (int c0 = 0; c0 < NCH; c0 += 32) { unsigned kv[32]; f32x2_t dc[32];
#pragma unroll
                for (int i = 0; i < 32; ++i) { kv[i] = S[(size_t)(c0 + i) * 8192]; dc[i] = *(const f32x2_t*)(dp + (c0 + i) * 256); }
#pragma unroll
                for (int i = 0; i < 32; ++i) { SB[(size_t)(c0 + i) * 8192] = pk2(s0, s1); s0 = s0 * dc[i].x + __uint_as_float(kv[i] << 16); s1 = s1 * dc[i].y + __uint_as_float(kv[i] & 0xffff0000u); } }
        }
    }
}

__device__ __forceinline__ void final_norm(const Args& a, unsigned char* ws, int tid) {
    const int lane = tid & 63, gw = blockIdx.x * 8 + (tid >> 6), NGW = gridDim.x * 8;
    const float* ssq = (const float*)(ws + WS_SSQ); const float* fw = in_ptr(a, I_FNW); const bf16_t* xb = (const bf16_t*)(ws + WS_XB);
    f32x4 w0[2], w1[2];
#pragma unroll
    for (int j = 0; j < 2; ++j) { w0[j] = *(const f32x4*)(fw + 512 * j + 8 * lane); w1[j] = *(const f32x4*)(fw + 512 * j + 8 * lane + 4); }
    for (int m = gw; m < MROWS; m += NGW) { const float rs = rstd_of(ssq, m);
#pragma unroll
        for (int j = 0; j < 2; ++j) { float t[8]; ld8bf(xb + (size_t)m * DM + 512 * j + 8 * lane, t);
            const f32x4 o0 = (f32x4){t[0], t[1], t[2], t[3]} * rs * w0[j], o1 = (f32x4){t[4], t[5], t[6], t[7]} * rs * w1[j];
            float* op = a.out + (size_t)m * DM + 512 * j + 8 * lane; *(f32x4*)op = o0; *(f32x4*)(op + 4) = o1; } }
}

#define XB_TMO      128
#define XB_XCNT(j)  (256  + 64 * (j))
#define XB_XSUB(j)  (1280 + 64 * (j))
#define XB_XGEN(j)  (2304 + 64 * (j))
#define XB_TOP      3328
#define XB_TOPGEN   3392
#define XCD_BAR_WORDS 3456
#define XB_SPIN_CAP (1u << 18)

__device__ __forceinline__ unsigned xb_ld(unsigned* p)              { return __hip_atomic_load(p, __ATOMIC_RELAXED, __HIP_MEMORY_SCOPE_AGENT); }
__device__ __forceinline__ unsigned xb_add(unsigned* p, unsigned v) { return __hip_atomic_fetch_add(p, v, __ATOMIC_RELAXED, __HIP_MEMORY_SCOPE_AGENT); }
__device__ __forceinline__ unsigned xb_xcc_id() { return (unsigned)__builtin_amdgcn_s_getreg((3 << 11) | 20) & 0xFu; }
#define XB_SPIN(cond, bar) do { unsigned _sp = 0; while (cond) { __builtin_amdgcn_s_sleep(1); \
    if ((++_sp & 255u) == 0u) { if (xb_ld(&(bar)[XB_TMO])) break; if (_sp > XB_SPIN_CAP) { atomicAdd(&(bar)[XB_TMO], 1u); break; } } } } while (0)

struct XcdBarrier {
    unsigned* bar; unsigned x;
    volatile LAS unsigned* st;
};

__device__ __forceinline__ XcdBarrier xcd_barrier_post(unsigned* bar, volatile LAS unsigned* st) {
    XcdBarrier b; b.bar = bar; b.x = xb_xcc_id(); b.st = st;
    if (threadIdx.x == 0) (void)xb_add(&bar[XB_XCNT(b.x)], 1u);
    return b;
}
__device__ __forceinline__ void xcd_barrier_complete(unsigned* bar, unsigned x, unsigned& nloc, unsigned& nx) {
    const unsigned G = gridDim.x * gridDim.y * gridDim.z;
    unsigned sum, cnt, mine, sp = 0u;
    for (;;) {
        sum = 0u; cnt = 0u; mine = 0u;
#pragma unroll
        for (unsigned j = 0; j < 16; ++j) { const unsigned c = xb_ld(&bar[XB_XCNT(j)]); sum += c; cnt += (c > 0u) ? 1u : 0u; mine = (j == x) ? c : mine; }
        if (sum == G) break;
        __builtin_amdgcn_s_sleep(1);
        if ((++sp & 255u) == 0u) { if (xb_ld(&bar[XB_TMO])) break; if (sp > XB_SPIN_CAP) { atomicAdd(&bar[XB_TMO], 1u); break; } }
    }
    nloc = mine > 0u ? mine : 1u; nx = cnt > 0u ? cnt : 1u;
}

__device__ __forceinline__ void xcd_barrier(const XcdBarrier& b, const bool lead  ) {
    asm volatile("s_waitcnt vmcnt(0)" ::: "memory");
    __syncthreads();
    if (lead) {
        unsigned* bar = b.bar;
        __builtin_amdgcn_s_waitcnt(0);
        unsigned nloc = b.st[0], nx = b.st[1];
        if (nloc == 0u) { xcd_barrier_complete(bar, b.x, nloc, nx); b.st[0] = nloc; b.st[1] = nx; }
        const unsigned old = xb_add(&bar[XB_XSUB(b.x)], 1u);
        const unsigned gen = old / nloc;
        if (old + 1u == (gen + 1u) * nloc) {
            __builtin_amdgcn_fence(__ATOMIC_RELEASE, "agent");
            asm volatile("s_waitcnt vmcnt(0)" ::: "memory");
            const unsigned og = xb_add(&bar[XB_TOP], 1u);
            const unsigned tg = og / nx;
            if (og + 1u == (tg + 1u) * nx) xb_add(&bar[XB_TOPGEN], 1u);
            else XB_SPIN(xb_ld(&bar[XB_TOPGEN]) == tg, bar);
            __builtin_amdgcn_fence(__ATOMIC_ACQUIRE, "agent");
            xb_add(&bar[XB_XGEN(b.x)], 1u);
            asm volatile("s_waitcnt vmcnt(0)" ::: "memory");
        } else {
            XB_SPIN(xb_ld(&bar[XB_XGEN(b.x)]) == gen, bar);
            __builtin_amdgcn_fence(__ATOMIC_ACQUIRE, "agent");
            asm volatile("s_waitcnt vmcnt(0)" ::: "memory");
        }
    }
    __syncthreads();
}

#ifdef OFF_P0
#define ON_P0(...)
#else
#define ON_P0(...) __VA_ARGS__
#endif
#ifdef OFF_FN
#define ON_FN(...)
#else
#define ON_FN(...) __VA_ARGS__
#endif
#ifdef OFF_G1
#define ON_G1(...)
#else
#define ON_G1(...) __VA_ARGS__
#endif
#ifdef OFF_M2
#define ON_M2(...)
#else
#define ON_M2(...) __VA_ARGS__
#endif
#ifdef OFF_MX
#define ON_MX(...)
#else
#define ON_MX(...) __VA_ARGS__
#endif
#ifdef OFF_G2
#define ON_G2(...)
#else
#define ON_G2(...) __VA_ARGS__
#endif
#ifdef OFF_G3
#define ON_G3(...)
#else
#define ON_G3(...) __VA_ARGS__
#endif
#ifdef OFF_G4
#define ON_G4(...)
#else
#define ON_G4(...) __VA_ARGS__
#endif
constexpr int N_PHASES = 16;
__global__ void __launch_bounds__(NTHREADS, 2) fwd_kernel(Args a) {
    extern __shared__ __attribute__((aligned(16))) unsigned char lds_raw[];
    LAS unsigned char* lds = (LAS unsigned char*)lds_raw;
    { volatile LAS unsigned* st = (volatile LAS unsigned*)(lds + LDS_PHASE); if (threadIdx.x < 2) st[threadIdx.x] = 0u; }
    __syncthreads();
    const XcdBarrier bar = xcd_barrier_post((unsigned*)a.ws, (volatile LAS unsigned*)(lds + LDS_PHASE));
    const int wave_s = __builtin_amdgcn_readfirstlane(threadIdx.x >> 6);
    for (int ph = a.ph_lo; ph < a.ph_hi; ++ph) {
        unsigned char* ws = a.ws; asm volatile("" : "+s"(ws));
        bf16_t* xb = (bf16_t*)(ws + WS_XB); bf16_t* r1 = (bf16_t*)(ws + WS_R1); bf16_t* yb = (bf16_t*)(ws + WS_Y); float* ssq = (float*)(ws + WS_SSQ);
        int tid; asm volatile("v_mbcnt_lo_u32_b32 %0, -1, 0\n\tv_mbcnt_hi_u32_b32 %0, -1, %0" : "=v"(tid)); tid += wave_s * 64;
        if (ph == 0) { ON_P0(p0_prologue(a, ws, lds, tid);)
#ifdef DUP_P0
            __syncthreads(); p0_prologue(a, ws, lds, tid);
#endif
        }
        else if (ph == N_PHASES - 1) { ON_FN(final_norm(a, ws, tid);) }
        else {
            const int l = (ph - 1) / 7, k = (ph - 1) % 7;
            if (k == 0) {
                pg8::Gemm g{xb, (const bf16_t*)(ws + WS_WIN) + (size_t)l * NIN * DM, DM}; pg8::StaticOrder S; S.init(MROWS / 256, NIN / 256, gridDim.x, blockIdx.x);
                pg8::EpiProj E{r1, ssq}; ON_G1(pg8::gemm_phase<pg8::EpiProj, false>(lds, g, S, E, tid);)
#ifdef DUP_G1
                __syncthreads(); pg8::gemm_phase<pg8::EpiProj, false>(lds, g, S, E, tid);
#endif
            } else if (k >= 1 && k <= 3) {
                MixCtx c; c.l = l; c.ws = ws; c.sb = (unsigned char*)a.out; c.lds = lds; c.tid = tid; c.lane = tid & 63; c.wave = tid >> 6; c.proj = r1; c.y = yb;
                if (k == 2) { ON_M2(mix_m2(c);)
#ifdef DUP_M2
                    __syncthreads(); mix_m2(c);
#endif
                } else if (k == 1) { ON_MX(mix_phase<1>(a, c);) } else { ON_MX(mix_phase<3>(a, c);) }
#ifdef DUP_M1
                if (k == 1) { __syncthreads(); mix_phase<1>(a, c); }
#endif
            } else if (k == 4) {
                pg8::Gemm g{yb, (const bf16_t*)(ws + WS_WOUT) + (size_t)l * DM * DM, DM}; pg8::StaticOrder S; S.init(MROWS / 256, DM / 256, gridDim.x, blockIdx.x);
                pg8::EpiResid E{l == 0 ? in_ptr(a, I_X) : nullptr, xb, ssq}; ON_G2(pg8::gemm_phase<pg8::EpiResid, false>(lds, g, S, E, tid);)
#ifdef DUP_G2
                if (l == 0) { __syncthreads(); pg8::gemm_phase<pg8::EpiResid, false>(lds, g, S, E, tid); }
#endif
            } else if (k == 5) {
                pg8::Gemm g{xb, (const bf16_t*)(ws + WS_WUP) + (size_t)l * NUP * DM, DM}; pg8::StaticOrder S; S.init(BATCH * UPU, NUP / 256, gridDim.x, blockIdx.x);
                pg8::EpiFfn E{r1, ssq, in_ptr(a, I_FCW) + (size_t)l * 3 * NUP, in_ptr(a, I_FCB) + (size_t)l * NUP}; ON_G3(pg8::gemm_phase<pg8::EpiFfn, true>(lds, g, S, E, tid);)
#ifdef DUP_G3
                __syncthreads(); pg8::gemm_phase<pg8::EpiFfn, true>(lds, g, S, E, tid);
#endif
            } else {
                pg8::Gemm g{r1, (const bf16_t*)(ws + WS_WDN) + (size_t)l * DM * DFF, DFF}; pg8::StaticOrder S; S.init(MROWS / 256, DM / 256, gridDim.x, blockIdx.x);
                pg8::EpiResid E{nullptr, xb, ssq}; ON_G4(pg8::gemm_phase<pg8::EpiResid, false>(lds, g, S, E, tid);)
            }
        }
        if (ph + 1 < a.ph_hi) { if (a.ph_hi > N_PHASES) { __syncthreads(); cg::this_grid().sync(); } else xcd_barrier(bar, tid == 0); }
    }
}

extern "C" void kernel_launch(void* const* d_in, const int* in_sizes, int n_in, void* d_out, int out_size, void* d_ws, size_t ws_size, hipStream_t stream) {
    static int grid = 0;
    if (grid == 0) {
        if (n_in != 20 || in_sizes[0] != MROWS * DM || out_size != MROWS * DM || ws_size < WS_END) {
            fprintf(stderr, "kernel_launch: unexpected problem: n_in %d in0 %d out %d ws %zu (need %zu)\n", n_in, n_in > 0 ? in_sizes[0] : -1, out_size, ws_size, (size_t)WS_END); grid = -1; return; }
        int dev = 0, cus = 0, per_cu = 0;
        (void)hipGetDevice(&dev); (void)hipDeviceGetAttribute(&cus, hipDeviceAttributeMultiprocessorCount, dev);
        if (hipFuncSetAttribute((const void*)fwd_kernel, hipFuncAttributeMaxDynamicSharedMemorySize, LDS_BYTES) != hipSuccess) { fprintf(stderr, "kernel_launch: hipFuncSetAttribute failed\n"); grid = -1; return; }
        if (hipOccupancyMaxActiveBlocksPerMultiprocessor(&per_cu, (const void*)fwd_kernel, NTHREADS, LDS_BYTES) != hipSuccess || per_cu < 1) { fprintf(stderr, "kernel_launch: occupancy query says %d\n", per_cu); per_cu = 1; }
        (void)hipGetLastError();
        grid = cus > 0 ? cus : 256;
    }
    if (grid < 0) return;
    Args a{};
    for (int i = 0; i < 20; ++i) a.in[i] = (const float*)d_in[i];
    a.out = (float*)d_out; a.ws = (unsigned char*)d_ws;
#if MK_ONE_LAUNCH
    if (hipMemsetAsync(d_ws, 0, XCD_BAR_WORDS * 4, stream) != hipSuccess) { fprintf(stderr, "kernel_launch: hipMemsetAsync failed\n"); return; }
    a.ph_lo = 0; a.ph_hi = N_PHASES;
    void* args[] = {&a};
    hipError_t e = hipLaunchCooperativeKernel((const void*)fwd_kernel, dim3(grid), dim3(NTHREADS), args, LDS_BYTES, stream);
    if (e != hipSuccess) fprintf(stderr, "kernel_launch: cooperative launch failed: %s (grid %d)\n", hipGetErrorString(e), grid);
#else
    for (int ph = 0; ph < N_PHASES; ++ph) { a.ph_lo = ph; a.ph_hi = ph + 1; hipLaunchKernelGGL(fwd_kernel, dim3(grid), dim3(NTHREADS), LDS_BYTES, stream, a); }
#endif
}
```
